# Optimizing an MI355X kernel written in HIP

```python
import math
import jax, jax.numpy as jnp
from jax import lax
import numpy as np

D_MODEL = 1024
BATCH = 16
SEQ = 256
DEPTH = 1
DEC_BATCH = 8
DEC_SEQ = 1024
PAST_LEN = 512

GRID_W = 64
N_DIFF_HEADS = 6
DIFF_HEAD_DIM = 64
DIFF_V_DIM = 2 * DIFF_HEAD_DIM
N_FOURIER_HEADS = 4
FOURIER_HEAD_DIM = 64
D_FOURIER = N_FOURIER_HEADS * FOURIER_HEAD_DIM
D_ATTN = N_DIFF_HEADS * DIFF_V_DIM
D_MIX = D_FOURIER + D_ATTN
D_QK = N_DIFF_HEADS * 2 * DIFF_HEAD_DIM
D_IN = D_FOURIER + 2 * D_QK + D_ATTN
D_FF = 2816
CONV_W = 3
ROPE_THETA = 10000.0
EPS = 1e-6
Q_BLOCK = 128

kernel_name = 'hybrid_fnet_diffattn_dit_step'


def rmsnorm(x, g):
    xf = x.astype(jnp.float32)
    y = xf * lax.rsqrt(jnp.mean(xf * xf, axis=-1, keepdims=True) + EPS)
    return (y * g.astype(jnp.float32)).astype(x.dtype)


def ada_modulation(cond, w_ada, b_ada):
    m = jax.nn.silu(cond) @ w_ada + b_ada
    return jnp.split(m[:, None, :], 6, axis=-1)


def axial_rope_tables(n_tokens):
    rows = n_tokens // GRID_W
    row = jnp.repeat(jnp.arange(rows, dtype=jnp.float32), GRID_W)
    col = jnp.tile(jnp.arange(GRID_W, dtype=jnp.float32), rows)
    n_freq = DIFF_HEAD_DIM // 4
    inv = ROPE_THETA ** (-jnp.arange(n_freq, dtype=jnp.float32) / n_freq)
    ang_r = (row[:, None] * inv)[:, None, :]
    ang_c = (col[:, None] * inv)[:, None, :]
    return (jnp.cos(ang_r), jnp.sin(ang_r), jnp.cos(ang_c), jnp.sin(ang_c))


def rope_half(x, cos, sin):
    x1, x2 = jnp.split(x, 2, axis=-1)
    cos = cos.astype(x.dtype)
    sin = sin.astype(x.dtype)
    return jnp.concatenate([x1 * cos - x2 * sin, x2 * cos + x1 * sin], axis=-1)


def apply_axial_rope(x, cos_r, sin_r, cos_c, sin_c):
    xr, xc = jnp.split(x, 2, axis=-1)
    return jnp.concatenate([rope_half(xr, cos_r, sin_r), rope_half(xc, cos_c, sin_c)], axis=-1)


def fourier_mix(xf):
    B, S, _ = xf.shape
    z = xf.reshape(B, S, N_FOURIER_HEADS, FOURIER_HEAD_DIM).astype(jnp.float32)
    y = jnp.fft.fftn(z, axes=(1, 3), norm='ortho').real
    return y.reshape(B, S, D_FOURIER).astype(xf.dtype)


def diff_attention(q, k, v, lam):
    B, H, Sq = q.shape[:3]
    nb = Sq // Q_BLOCK
    qb = q.reshape(B, H, nb, Q_BLOCK, 2, DIFF_HEAD_DIM).transpose(2, 0, 1, 3, 4, 5)
    scale = DIFF_HEAD_DIM ** -0.5

    def block(qblk):
        s = jnp.einsum('bhqcd,bhkcd->bhcqk', qblk, k).astype(jnp.float32) * scale
        p = jax.nn.softmax(s, axis=-1)
        a = p[:, :, 0] - lam * p[:, :, 1]
        return jnp.einsum('bhqk,bhkd->bhqd', a.astype(v.dtype), v)

    o = lax.map(block, qb)
    return o.transpose(1, 2, 0, 3, 4).reshape(B, H, Sq, DIFF_V_DIM)


def conv_glu(h, w_gate, w_up, conv_w, conv_b, w_down):
    g = h @ w_gate
    gp = jnp.pad(g, ((0, 0), (1, 1), (0, 0)))
    g = gp[:, :-2] * conv_w[0] + gp[:, 1:-1] * conv_w[1] + gp[:, 2:] * conv_w[2] + conv_b
    return (jax.nn.silu(g) * (h @ w_up)) @ w_down


def trunk_layer(x, cond, lp, layer_idx, rope, k_ctx, v_ctx):
    (n1, n2, w_ada, b_ada, w_in, qg, kg, lq1, lk1, lq2, lk2, subg, w_out,
     w_gate, w_up, conv_w, conv_b, w_down) = lp
    B, S, _ = x.shape
    shift1, scale1, gate1, shift2, scale2, gate2 = ada_modulation(cond, w_ada, b_ada)

    h = rmsnorm(x, n1) * (1 + scale1) + shift1
    proj = h @ w_in
    xf, q, k, v = jnp.split(proj, [D_FOURIER, D_FOURIER + D_QK, D_FOURIER + 2 * D_QK], axis=-1)
    q = rmsnorm(q.reshape(B, S, N_DIFF_HEADS, 2, DIFF_HEAD_DIM), qg).transpose(0, 2, 1, 3, 4)
    k = rmsnorm(k.reshape(B, S, N_DIFF_HEADS, 2, DIFF_HEAD_DIM), kg).transpose(0, 2, 1, 3, 4)
    v = v.reshape(B, S, N_DIFF_HEADS, DIFF_V_DIM).transpose(0, 2, 1, 3)
    if rope is not None:
        q = apply_axial_rope(q, *rope)
        k = apply_axial_rope(k, *rope)
    if k_ctx is not None:
        k_all = jnp.concatenate([k, k_ctx.astype(k.dtype)], axis=2)
        v_all = jnp.concatenate([v, v_ctx.astype(v.dtype)], axis=2)
    else:
        k_all, v_all = k, v
    lam_init = 0.8 - 0.6 * math.exp(-0.3 * layer_idx)
    lam = (jnp.exp(jnp.sum(lq1.astype(jnp.float32) * lk1.astype(jnp.float32)))
           - jnp.exp(jnp.sum(lq2.astype(jnp.float32) * lk2.astype(jnp.float32))) + lam_init)
    o = diff_attention(q, k_all, v_all, lam)
    o = rmsnorm(o, subg) * (1.0 - lam_init)
    o = o.transpose(0, 2, 1, 3).reshape(B, S, D_ATTN)
    mix = jnp.concatenate([fourier_mix(xf), o], axis=-1) @ w_out
    x = x + gate1 * mix

    h2 = rmsnorm(x, n2) * (1 + scale2) + shift2
    x = x + gate2 * conv_glu(h2, w_gate, w_up, conv_w, conv_b, w_down)
    return x, k, v


def setup_inputs(seed: int = 0) -> dict:
    key = jax.random.key(seed)
    ks = jax.random.split(key, 26)
    f32 = jnp.float32

    def nrm(k, shape, s):
        return jax.random.normal(k, shape, f32) * s

    return {
        'x_prompt': nrm(ks[0], (BATCH, SEQ, D_MODEL), 1.0),
        'x_sample': nrm(ks[1], (DEC_BATCH, DEC_SEQ, D_MODEL), 1.0),
        'cache_k': nrm(ks[2], (DEC_BATCH, DEPTH, N_DIFF_HEADS, PAST_LEN, 2, DIFF_HEAD_DIM), 1.0),
        'cache_v': nrm(ks[3], (DEC_BATCH, DEPTH, N_DIFF_HEADS, PAST_LEN, DIFF_V_DIM), 1.0),
        'c': nrm(ks[4], (DEC_BATCH, D_MODEL), 1.0),
        'c_ctx': nrm(ks[5], (D_MODEL,), 1.0),
        'norm1_g': 1.0 + nrm(ks[6], (DEPTH, D_MODEL), 0.02),
        'norm2_g': 1.0 + nrm(ks[7], (DEPTH, D_MODEL), 0.02),
        'w_ada': nrm(ks[8], (DEPTH, D_MODEL, 6 * D_MODEL), 0.5 * D_MODEL ** -0.5),
        'b_ada': nrm(ks[9], (DEPTH, 6 * D_MODEL), 0.02),
        'w_in': nrm(ks[10], (DEPTH, D_MODEL, D_IN), D_MODEL ** -0.5),
        'q_norm_g': 1.0 + nrm(ks[11], (DEPTH, DIFF_HEAD_DIM), 0.02),
        'k_norm_g': 1.0 + nrm(ks[12], (DEPTH, DIFF_HEAD_DIM), 0.02),
        'lam_q1': nrm(ks[13], (DEPTH, DIFF_HEAD_DIM), 0.1),
        'lam_k1': nrm(ks[14], (DEPTH, DIFF_HEAD_DIM), 0.1),
        'lam_q2': nrm(ks[15], (DEPTH, DIFF_HEAD_DIM), 0.1),
        'lam_k2': nrm(ks[16], (DEPTH, DIFF_HEAD_DIM), 0.1),
        'subln_g': 1.0 + nrm(ks[17], (DEPTH, DIFF_V_DIM), 0.02),
        'w_out': nrm(ks[18], (DEPTH, D_MIX, D_MODEL), D_MIX ** -0.5),
        'w_gate': nrm(ks[19], (DEPTH, D_MODEL, D_FF), D_MODEL ** -0.5),
        'w_up': nrm(ks[20], (DEPTH, D_MODEL, D_FF), D_MODEL ** -0.5),
        'conv_w': nrm(ks[21], (DEPTH, CONV_W, D_FF), CONV_W ** -0.5),
        'conv_b': nrm(ks[22], (DEPTH, D_FF), 0.02),
        'w_down': nrm(ks[23], (DEPTH, D_FF, D_MODEL), D_FF ** -0.5),
    }


def reference(x_prompt, x_sample, cache_k, cache_v, c, c_ctx,
              norm1_g, norm2_g, w_ada, b_ada, w_in, q_norm_g, k_norm_g,
              lam_q1, lam_k1, lam_q2, lam_k2, subln_g, w_out,
              w_gate, w_up, conv_w, conv_b, w_down):
    rope = axial_rope_tables(x_sample.shape[1])
    y_p = x_prompt
    y_s = x_sample
    k_list, v_list = [], []
    for i in range(DEPTH):
        lp = (norm1_g[i], norm2_g[i], w_ada[i], b_ada[i], w_in[i], q_norm_g[i], k_norm_g[i],
              lam_q1[i], lam_k1[i], lam_q2[i], lam_k2[i], subln_g[i], w_out[i],
              w_gate[i], w_up[i], conv_w[i], conv_b[i], w_down[i])
        y_p, k_i, v_i = trunk_layer(y_p, c_ctx[None, :], lp, i, None, None, None)
        k_list.append(k_i)
        v_list.append(v_i)
        y_s, _, _ = trunk_layer(y_s, c, lp, i, rope, cache_k[:, i], cache_v[:, i])
    new_k = jnp.stack(k_list, axis=1)
    new_v = jnp.stack(v_list, axis=1)
    return (y_p, y_s, new_k, new_v)
```

```cpp
#include <hip/hip_runtime.h>
#include <cstdio>
#include <cstdint>

#ifndef MK_N_LAUNCHES
#define MK_N_LAUNCHES 1
#endif
#define LAS __attribute__((address_space(3)))
#define GAS __attribute__((address_space(1)))
typedef unsigned short bf16_t;
typedef short bf16x8 __attribute__((ext_vector_type(8)));
typedef short s16x4 __attribute__((ext_vector_type(4)));
typedef float f32x2 __attribute__((ext_vector_type(2)));
typedef float f32x4 __attribute__((ext_vector_type(4)));
typedef float f32x16 __attribute__((ext_vector_type(16)));
typedef unsigned u32x2 __attribute__((ext_vector_type(2)));
typedef unsigned u32x4 __attribute__((ext_vector_type(4)));
typedef __bf16 bf16x2_t __attribute__((ext_vector_type(2)));
typedef GAS unsigned gu32;
#define RLX_AGENT __ATOMIC_RELAXED, __HIP_MEMORY_SCOPE_AGENT
#define LDS_WAIT() asm volatile("s_waitcnt lgkmcnt(0)" ::: "memory")
#define VM_WAIT() asm volatile("s_waitcnt vmcnt(0)" ::: "memory")
__device__ __forceinline__ unsigned pk2(float lo, float hi) { f32x2 v = {lo, hi}; bf16x2_t b = __builtin_convertvector(v, bf16x2_t); return __builtin_bit_cast(unsigned, b); }
__device__ __forceinline__ bf16_t f2bf(float x) { return (bf16_t)(pk2(x, 0.f) & 0xffffu); }
__device__ __forceinline__ float wave_sum(float v) {
#pragma unroll
    for (int o = 1; o < 64; o <<= 1) v += __shfl_xor(v, o);
    return v;
}
__device__ __forceinline__ float wave_max(float v) {
#pragma unroll
    for (int o = 1; o < 64; o <<= 1) v = fmaxf(v, __shfl_xor(v, o));
    return v;
}

constexpr int DM = 1024, NTOK = 12288, NTOK_P = 4096, NH = 6;
constexpr int SP = 256, SS = 1024, SKS = 1536, PAST = 512;
constexpr int DIN = 2560, DFF = 2816, KOUT = 1280, NGU = 5632, NADA = 6144;
constexpr float EPS = 1e-6f;
constexpr float C2 = 0.125f * 1.4426950408889634f;
constexpr float ONE_M_LAMINIT = 0.8f, LAM_INIT = 0.2f;

constexpr size_t MiB = 1u << 20;
constexpr size_t WS_CTL = 0, CTL_ZERO_BYTES = 1 * MiB;
constexpr size_t WS_ADA = 1 * MiB;
constexpr size_t WS_BIAS2 = 1 * MiB + 256 * 1024;
constexpr size_t WS_ROPE = 1 * MiB + 512 * 1024;
constexpr size_t WS_SSQ = 2 * MiB;
constexpr size_t WS_WIN = 3 * MiB;
constexpr size_t WS_WOUT = 8 * MiB;
constexpr size_t WS_WGU = 11 * MiB;
constexpr size_t WS_WDN = 22 * MiB;
constexpr size_t WS_DFTS = 28 * MiB;
constexpr size_t WS_DFTP = 32 * MiB;
constexpr size_t WS_H = 33 * MiB;
constexpr size_t WS_XFT_P = 58 * MiB, WS_XFT_S = 60 * MiB;
constexpr size_t WS_Q_P = 64 * MiB, WS_Q_S = 70 * MiB;
constexpr size_t WS_K_P = 82 * MiB, WS_K_S = 88 * MiB;
constexpr size_t WS_V_P = 106 * MiB, WS_V_S = 112 * MiB;
constexpr size_t WS_MIX = 130 * MiB;
constexpr size_t WS_G = 58 * MiB, WS_U = 124 * MiB;
constexpr size_t WS_END = 190 * MiB;
constexpr int CW_TMO = 0, CW_CODE = 1, CW_KMAX = 64, CW_BAR = 4096;

constexpr int RING_OFF = 0, RING_BYTES = 131072;
constexpr int ATT_WSC_OFF = RING_BYTES;
constexpr int LDSCTL_OFF = RING_BYTES + 2048, MISC_OFF = LDSCTL_OFF + 320;
constexpr int LDS_BYTES = 147456;
constexpr int NWAVES = 8;
namespace pg8 {
#define PG8_LAS __attribute__((address_space(3)))
typedef unsigned short bf16_t;
typedef short bf16x8 __attribute__((ext_vector_type(8)));
typedef float f32x4 __attribute__((ext_vector_type(4)));
typedef unsigned u32x4 __attribute__((ext_vector_type(4)));
constexpr int BM = 256, BK = 64, HALF = 128, HTB = HALF * BK * 2  , STAGE_BYTES = 8 * HTB, NXCD = 8, WGM = 8;

__host__ __device__ __forceinline__ int lds_byte(int r, int c) { const int st = (r >> 4) * 2 + (c >> 5), rr = r & 15, cc = c & 31, ob = rr * 64 + cc * 2; return st * 1024 + (ob ^ (((ob >> 9) & 1) << 5)); }
__host__ __device__ __forceinline__ void stage_rc(int b, int& R, int& C) { const int st = b / 1024, sb = b % 1024, swz = sb ^ (((sb >> 9) & 1) << 5); R = (st >> 1) * 16 + swz / 64; C = (st & 1) * 32 + (swz % 64) / 2; }
__host__ __device__ __forceinline__ int perm32(int rho) { const int n = rho >> 4, i = rho & 15; return 8 * (i >> 2) + 4 * n + (i & 3); }

struct Unit { int pm, pn; };
struct Gemm { const bf16_t* A; const bf16_t* Bt; int M, N, K; };

struct StaticOrder {
    int nM, nN, nwg, G, c;
    __host__ __device__ void init(int M, int N, int G_, int c_) { nM = M / BM; nN = N / BM; nwg = nM * nN; G = G_; c = c_; }
    __host__ __device__ bool next(int i, Unit& u) const {
        const long L = (long)i * G + c; if (L >= nwg) return false;
        int wgid = (int)L; { const int q = nwg / NXCD, r = nwg % NXCD, xcd = wgid % NXCD, off = wgid / NXCD; wgid = (xcd < r ? xcd * (q + 1) : r * (q + 1) + (xcd - r) * q) + off; }
        const int nig = WGM * nN, gid = wgid / nig, fm = gid * WGM, gsz = (nM - fm) < WGM ? (nM - fm) : WGM;
        u.pm = fm + ((wgid % nig) % gsz); u.pn = (wgid % nig) / gsz; return true;
    }
    __device__ __forceinline__ void a_ready(const Unit&) const {}
    __device__ __forceinline__ void done(const Unit&) const {}
};

__device__ __forceinline__ unsigned cvt_pk_bf16(float lo, float hi) { unsigned r; asm volatile("v_cvt_pk_bf16_f32 %0, %1, %2" : "=v"(r) : "v"(lo), "v"(hi)); return r; }
template <class Epi, class Sched, bool ALIGN_EPI = false, bool SP2 = false>
__device__ __forceinline__ void gemm_phase(PG8_LAS unsigned char* lds, const Gemm g, const Sched& S, const Epi& E) {
    const int tid = threadIdx.x, wid = __builtin_amdgcn_readfirstlane(tid >> 6), lane = tid & 63, wr = wid >> 2, wc = wid & 3, fr = lane & 15, fq = lane >> 4;
    const int K = g.K, nt = K / BK;
    unsigned voffA[2], voffB[2];
#pragma unroll
    for (int i = 0; i < 2; ++i) { int R, C; stage_rc(tid * 16 + i * 8192, R, C); const int Rb = Epi::PERM ? ((R & ~31) + perm32(R & 31)) : R;
        voffA[i] = (unsigned)(R * K + C) * 2u; voffB[i] = (unsigned)(Rb * K + C) * 2u; }
    const size_t kstep = (size_t)(BK * 2);
    const size_t hstep = (size_t)HALF * K * 2;
    const size_t tstep = 2 * hstep;
    const unsigned ldsw = (unsigned)wid * 1024u;
    const int aoff = lds_byte(wr * 64 + fr, fq * 8), boff = lds_byte(wc * 32 + fr, fq * 8);
#define PG8_SA(b, h) (((b) * 2 + (h)) * HTB)
#define PG8_SB(b, h) ((4 + (b) * 2 + (h)) * HTB)
#define PG8_STAGE(bufoff, gbase, voff) do { _Pragma("unroll") for (int _i = 0; _i < 2; ++_i) \
        __builtin_amdgcn_global_load_lds((const unsigned*)((const char*)(gbase) + (voff)[_i]), (PG8_LAS unsigned*)(lds + (bufoff) + ldsw + _i * 8192), 16, 0, 0); } while (0)
#define PG8_LDA(dst, b, h) do { _Pragma("unroll") for (int m = 0; m < 4; ++m) _Pragma("unroll") for (int k = 0; k < 2; ++k) dst[m][k] = *(const PG8_LAS bf16x8*)(lds + PG8_SA(b, h) + aoff + m * 2048 + k * 1024); } while (0)
#define PG8_LDB(dst, b, h) do { _Pragma("unroll") for (int n = 0; n < 2; ++n) _Pragma("unroll") for (int k = 0; k < 2; ++k) dst[n][k] = *(const PG8_LAS bf16x8*)(lds + PG8_SB(b, h) + boff + n * 2048 + k * 1024); } while (0)
#define PG8_MMA(ai, bj, At, Bt) do { __builtin_amdgcn_s_setprio(1); _Pragma("unroll") for (int m = 0; m < 4; ++m) _Pragma("unroll") for (int n = 0; n < 2; ++n) _Pragma("unroll") for (int k = 0; k < 2; ++k) \
        acc[ai][bj][m][n] = __builtin_amdgcn_mfma_f32_16x16x32_bf16(Bt[n][k], At[m][k], acc[ai][bj][m][n], 0, 0, 0); __builtin_amdgcn_s_setprio(0); } while (0)
#define PG8_WAIT_V(n) asm volatile("s_waitcnt vmcnt(" #n ")" ::: "memory")
#define PG8_WAIT_L(n) asm volatile("s_waitcnt lgkmcnt(" #n ")" ::: "memory")
#define PG8_BAR __builtin_amdgcn_s_barrier()
#define PG8_SCHED __builtin_amdgcn_sched_barrier(0)
    Unit cur, nxt; int ui = 0;
    if (!S.next(0, cur)) return;
    f32x4 acc[2][2][4][2];
#pragma unroll
    for (int a = 0; a < 2; ++a)
#pragma unroll
        for (int b = 0; b < 2; ++b)
#pragma unroll
            for (int m = 0; m < 4; ++m)
#pragma unroll
                for (int n = 0; n < 2; ++n) acc[a][b][m][n] = (f32x4){0.f, 0.f, 0.f, 0.f};
    bf16x8 At[4][2], B0[2][2], B1[2][2];
    const char* cA = (const char*)g.A + (size_t)cur.pm * tstep; const char* cB = (const char*)g.Bt + (size_t)cur.pn * tstep;
    S.a_ready(cur);
    if constexpr (SP2) {
        PG8_STAGE(PG8_SB(0, 0), cB, voffB); PG8_STAGE(PG8_SB(0, 1), cB + hstep, voffB); PG8_STAGE(PG8_SA(0, 0), cA, voffA); PG8_STAGE(PG8_SA(0, 1), cA + hstep, voffA);
        if (wr == 1) PG8_BAR;
        PG8_WAIT_V(2); PG8_BAR;
        PG8_STAGE(PG8_SB(1, 0), cB + kstep, voffB); PG8_STAGE(PG8_SA(1, 0), cA + kstep, voffA); PG8_STAGE(PG8_SB(1, 1), cB + hstep + kstep, voffB);
        PG8_WAIT_V(6); PG8_BAR;
    } else {
        PG8_STAGE(PG8_SB(0, 0), cB, voffB); PG8_STAGE(PG8_SA(0, 0), cA, voffA); PG8_STAGE(PG8_SB(0, 1), cB + hstep, voffB); PG8_STAGE(PG8_SA(0, 1), cA + hstep, voffA);
        if (wr == 1) PG8_BAR;
        PG8_WAIT_V(4); PG8_BAR;
        PG8_STAGE(PG8_SB(1, 0), cB + kstep, voffB); PG8_STAGE(PG8_SA(1, 0), cA + kstep, voffA); PG8_STAGE(PG8_SB(1, 1), cB + hstep + kstep, voffB);
        PG8_WAIT_V(6); PG8_BAR;
    }
    for (;;) {
        const bool has_next = S.next(ui + 1, nxt);
        const char* nA = has_next ? (const char*)g.A + (size_t)nxt.pm * tstep : cA; const char* nB = has_next ? (const char*)g.Bt + (size_t)nxt.pn * tstep : cB;
        for (int t = 0; t < nt; t += 2) {
            const bool last = (t == nt - 2);
            const char* a1 = cA + (size_t)(t + 1) * kstep;
            const char* a2 = last ? nA : cA + (size_t)(t + 2) * kstep; const char* b2 = last ? nB : cB + (size_t)(t + 2) * kstep;
            const char* a3 = a2 + kstep; const char* b3 = b2 + kstep;
            if (last && has_next) S.a_ready(nxt);
            if constexpr (SP2) {
            PG8_LDB(B0, 0, 0); PG8_LDB(B1, 0, 1); PG8_SCHED; PG8_LDA(At, 0, 0); PG8_STAGE(PG8_SA(1, 1), a1 + hstep, voffA);
            PG8_WAIT_V(8); PG8_WAIT_L(0); PG8_BAR; PG8_MMA(0, 0, At, B0); PG8_MMA(0, 1, At, B1); PG8_BAR; PG8_SCHED;
            PG8_LDA(At, 0, 1); PG8_STAGE(PG8_SB(0, 0), b2, voffB); PG8_STAGE(PG8_SB(0, 1), b2 + hstep, voffB); PG8_STAGE(PG8_SA(0, 0), a2, voffA);
            PG8_WAIT_V(8); PG8_WAIT_L(0); PG8_BAR; PG8_MMA(1, 0, At, B0); PG8_MMA(1, 1, At, B1); PG8_BAR; PG8_SCHED;
            PG8_LDB(B0, 1, 0); PG8_LDB(B1, 1, 1); PG8_SCHED; PG8_LDA(At, 1, 0); PG8_STAGE(PG8_SA(0, 1), a2 + hstep, voffA);
            PG8_WAIT_V(8); PG8_WAIT_L(0); PG8_BAR; PG8_MMA(0, 0, At, B0); PG8_MMA(0, 1, At, B1); PG8_BAR; PG8_SCHED;
            PG8_LDA(At, 1, 1); PG8_STAGE(PG8_SB(1, 0), b3, voffB); PG8_STAGE(PG8_SB(1, 1), b3 + hstep, voffB); PG8_STAGE(PG8_SA(1, 0), a3, voffA);
            PG8_WAIT_V(8); PG8_WAIT_L(0); PG8_BAR; PG8_MMA(1, 0, At, B0); PG8_MMA(1, 1, At, B1); PG8_BAR; PG8_SCHED;
            } else {
            PG8_LDB(B0, 0, 0); PG8_SCHED; PG8_LDA(At, 0, 0); PG8_STAGE(PG8_SA(1, 1), a1 + hstep, voffA);
            PG8_WAIT_L(8); PG8_BAR; PG8_WAIT_L(0); PG8_MMA(0, 0, At, B0); PG8_BAR; PG8_SCHED;
            PG8_LDB(B1, 0, 1); PG8_STAGE(PG8_SB(0, 0), b2, voffB);
            PG8_BAR; PG8_WAIT_L(0); PG8_MMA(0, 1, At, B1); PG8_BAR;
            PG8_LDA(At, 0, 1); PG8_STAGE(PG8_SA(0, 0), a2, voffA);
            PG8_BAR; PG8_WAIT_L(0); PG8_MMA(1, 0, At, B0); PG8_BAR; PG8_SCHED;
            PG8_STAGE(PG8_SB(0, 1), b2 + hstep, voffB);
            PG8_WAIT_V(6); PG8_BAR; PG8_MMA(1, 1, At, B1); PG8_BAR;
            PG8_LDB(B0, 1, 0); PG8_SCHED; PG8_LDA(At, 1, 0); PG8_STAGE(PG8_SA(0, 1), a2 + hstep, voffA);
            PG8_WAIT_L(8); PG8_BAR; PG8_WAIT_L(0); PG8_MMA(0, 0, At, B0); PG8_BAR; PG8_SCHED;
            PG8_LDB(B1, 1, 1); PG8_STAGE(PG8_SB(1, 0), b3, voffB);
            PG8_BAR; PG8_WAIT_L(0); PG8_MMA(0, 1, At, B1); PG8_BAR;
            PG8_LDA(At, 1, 1); PG8_STAGE(PG8_SA(1, 0), a3, voffA);
            PG8_BAR; PG8_WAIT_L(0); PG8_MMA(1, 0, At, B0); PG8_BAR; PG8_SCHED;
            PG8_STAGE(PG8_SB(1, 1), b3 + hstep, voffB);
            PG8_WAIT_V(6); PG8_BAR; PG8_MMA(1, 1, At, B1); PG8_BAR;
            }
        }
        if constexpr (ALIGN_EPI) { if (wr == 0) PG8_BAR; }
        if constexpr (!Epi::AFTER_DRAIN) { E(acc, cur, wr, wc, fr, fq); S.done(cur); }
        if (!has_next) break;
#pragma unroll
        for (int a = 0; a < 2; ++a)
#pragma unroll
            for (int b = 0; b < 2; ++b)
#pragma unroll
                for (int m = 0; m < 4; ++m)
#pragma unroll
                    for (int n = 0; n < 2; ++n) acc[a][b][m][n] = (f32x4){0.f, 0.f, 0.f, 0.f};
        cur = nxt; cA = nA; cB = nB; ++ui;
        if constexpr (ALIGN_EPI) { if (wr == 1) PG8_BAR; }
    }
    PG8_WAIT_V(0);
    if constexpr (!ALIGN_EPI) { if (wr == 0) PG8_BAR; }
    PG8_BAR;
    if constexpr (Epi::AFTER_DRAIN) { E.fused(acc, cur, wr, wc, fr, fq, lds, wid, lane); S.done(cur); }
#undef PG8_SA
#undef PG8_SB
#undef PG8_STAGE
#undef PG8_LDA
#undef PG8_LDB
#undef PG8_MMA
#undef PG8_WAIT_V
#undef PG8_WAIT_L
#undef PG8_BAR
#undef PG8_SCHED
}
}
#define XB_TMO      128
#define XB_XCNT(j)  (256  + 64 * (j))
#define XB_XSUB(j)  (1280 + 64 * (j))
#define XB_XGEN(j)  (2304 + 64 * (j))
#define XB_TOP      3328
#define XB_TOPGEN   3392
#define XCD_BAR_WORDS 3456
#define XB_SPIN_CAP (1u << 18)

__device__ __forceinline__ unsigned xb_ld(unsigned* p)              { return __hip_atomic_load(p, __ATOMIC_RELAXED, __HIP_MEMORY_SCOPE_AGENT); }
__device__ __forceinline__ unsigned xb_add(unsigned* p, unsigned v) { return __hip_atomic_fetch_add(p, v, __ATOMIC_RELAXED, __HIP_MEMORY_SCOPE_AGENT); }
__device__ __forceinline__ unsigned xb_xcc_id() { return (unsigned)__builtin_amdgcn_s_getreg((3 << 11) | 20) & 0xFu; }
#define XB_SPIN(cond, bar) do { unsigned _sp = 0; while (cond) { __builtin_amdgcn_s_sleep(1); \
    if ((++_sp & 255u) == 0u) { if (xb_ld(&(bar)[XB_TMO])) break; if (_sp > XB_SPIN_CAP) { atomicAdd(&(bar)[XB_TMO], 1u); break; } } } } while (0)

struct XcdBarrier {
    unsigned* bar; unsigned x;
    volatile LAS unsigned* st;
};

__device__ __forceinline__ XcdBarrier xcd_barrier_post(unsigned* bar, volatile LAS unsigned* st) {
    XcdBarrier b; b.bar = bar; b.x = xb_xcc_id(); b.st = st;
    if (threadIdx.x == 0) (void)xb_add(&bar[XB_XCNT(b.x)], 1u);
    return b;
}
__device__ __forceinline__ void xcd_barrier_complete(unsigned* bar, unsigned x, unsigned& nloc, unsigned& nx) {
    const unsigned G = gridDim.x * gridDim.y * gridDim.z;
    unsigned sum, cnt, mine, sp = 0u;
    for (;;) {
        sum = 0u; cnt = 0u; mine = 0u;
#pragma unroll
        for (unsigned j = 0; j < 16; ++j) { const unsigned c = xb_ld(&bar[XB_XCNT(j)]); sum += c; cnt += (c > 0u) ? 1u : 0u; mine = (j == x) ? c : mine; }
        if (sum == G) break;
        __builtin_amdgcn_s_sleep(1);
        if ((++sp & 255u) == 0u) { if (xb_ld(&bar[XB_TMO])) break; if (sp > XB_SPIN_CAP) { atomicAdd(&bar[XB_TMO], 1u); break; } }
    }
    nloc = mine > 0u ? mine : 1u; nx = cnt > 0u ? cnt : 1u;
}

__device__ __forceinline__ void xcd_barrier(const XcdBarrier& b) {
    asm volatile("s_waitcnt vmcnt(0)" ::: "memory");
    __syncthreads();
    if (threadIdx.x == 0) {
        unsigned* bar = b.bar;
        __builtin_amdgcn_s_waitcnt(0);
        unsigned nloc = b.st[0], nx = b.st[1];
        if (nloc == 0u) { xcd_barrier_complete(bar, b.x, nloc, nx); b.st[0] = nloc; b.st[1] = nx; }
        const unsigned old = xb_add(&bar[XB_XSUB(b.x)], 1u);
        const unsigned gen = old / nloc;
        if (old + 1u == (gen + 1u) * nloc) {
            __builtin_amdgcn_fence(__ATOMIC_RELEASE, "agent");
            asm volatile("s_waitcnt vmcnt(0)" ::: "memory");
            const unsigned og = xb_add(&bar[XB_TOP], 1u);
            const unsigned tg = og / nx;
            if (og + 1u == (tg + 1u) * nx) xb_add(&bar[XB_TOPGEN], 1u);
            else XB_SPIN(xb_ld(&bar[XB_TOPGEN]) == tg, bar);
            __builtin_amdgcn_fence(__ATOMIC_ACQUIRE, "agent");
            xb_add(&bar[XB_XGEN(b.x)], 1u);
            asm volatile("s_waitcnt vmcnt(0)" ::: "memory");
        } else {
            XB_SPIN(xb_ld(&bar[XB_XGEN(b.x)]) == gen, bar);
            __builtin_amdgcn_fence(__ATOMIC_ACQUIRE, "agent");
            asm volatile("s_waitcnt vmcnt(0)" ::: "memory");
        }
    }
    __syncthreads();
}
namespace attn {
constexpr int V_OFF = 0, K_OFF = 32768, EX_OFF = 65536;
#define ATT_KSWZ(row, colB) ((row) * 128 + ((colB) ^ ((((row) >> 1) & 7) << 4)))
#define ATT_SBAR() __builtin_amdgcn_sched_barrier(0)
__device__ __forceinline__ int crow(int r, int hi) { return (r & 3) + 8 * (r >> 2) + 4 * hi; }
__device__ __forceinline__ int v_st(int k, int c) { const int kk = (k & ~0xC) | ((k & 4) << 1) | ((k & 8) >> 1); return ((kk >> 3) * 4 + (c >> 5)) * 512 + ((kk & 7) * 32 + (c & 31)) * 2; }
__device__ __forceinline__ int v_rd_base(int lane) { return ((lane & 3) << 3) | (((lane >> 2) & 3) << 6) | (((lane >> 4) & 1) << 5) | (((lane >> 5) & 1) << 8); }
constexpr int v_rd_off(int d0, int ks, int half) { return d0 * 512 + ks * 4096 + half * 2048; }
template <int OFF> __device__ __forceinline__ s16x4 tr_read(int vb) {
    s16x4 r; asm volatile("ds_read_b64_tr_b16 %0, %1 offset:%2" : "=&v"(r) : "v"(vb), "i"(OFF) : "memory"); return r;
}
template <int D0> __device__ __forceinline__ void pv_one(f32x16& od, int vb, bf16x8 pa0, bf16x8 pa1, bf16x8 pa2, bf16x8 pa3) {
    const s16x4 l0 = tr_read<v_rd_off(D0, 0, 0)>(vb), h0 = tr_read<v_rd_off(D0, 0, 1)>(vb), l1 = tr_read<v_rd_off(D0, 1, 0)>(vb), h1 = tr_read<v_rd_off(D0, 1, 1)>(vb);
    const s16x4 l2 = tr_read<v_rd_off(D0, 2, 0)>(vb), h2 = tr_read<v_rd_off(D0, 2, 1)>(vb), l3 = tr_read<v_rd_off(D0, 3, 0)>(vb), h3 = tr_read<v_rd_off(D0, 3, 1)>(vb);
    asm volatile("s_waitcnt lgkmcnt(0)" ::: "memory"); ATT_SBAR();
#define ATT_PK(L, H) (bf16x8){L[0], L[1], L[2], L[3], H[0], H[1], H[2], H[3]}
    od = __builtin_amdgcn_mfma_f32_32x32x16_bf16(pa0, ATT_PK(l0, h0), od, 0, 0, 0);
    od = __builtin_amdgcn_mfma_f32_32x32x16_bf16(pa1, ATT_PK(l1, h1), od, 0, 0, 0);
    od = __builtin_amdgcn_mfma_f32_32x32x16_bf16(pa2, ATT_PK(l2, h2), od, 0, 0, 0);
    od = __builtin_amdgcn_mfma_f32_32x32x16_bf16(pa3, ATT_PK(l3, h3), od, 0, 0, 0);
#undef ATT_PK
}
__device__ __forceinline__ void pv_all(f32x16* o, int vb, bf16x8 pa0, bf16x8 pa1, bf16x8 pa2, bf16x8 pa3) {
    pv_one<0>(o[0], vb, pa0, pa1, pa2, pa3); pv_one<1>(o[1], vb, pa0, pa1, pa2, pa3); pv_one<2>(o[2], vb, pa0, pa1, pa2, pa3); pv_one<3>(o[3], vb, pa0, pa1, pa2, pa3);
}
__device__ __forceinline__ void qkt(f32x16& p0, f32x16& p1, const LAS unsigned char* Kt, const bf16x8* qr, float negref, int r32, int hi) {
#pragma unroll
    for (int r = 0; r < 16; ++r) { p0[r] = negref; p1[r] = negref; }
#pragma unroll
    for (int d0 = 0; d0 < 4; ++d0) { const int cb = (d0 * 16 + hi * 8) * 2;
        const bf16x8 b0 = *(const LAS bf16x8*)(Kt + ATT_KSWZ(r32, cb));
        const bf16x8 b1 = *(const LAS bf16x8*)(Kt + ATT_KSWZ(32 + r32, cb));
        p0 = __builtin_amdgcn_mfma_f32_32x32x16_bf16(b0, qr[d0], p0, 0, 0, 0);
        p1 = __builtin_amdgcn_mfma_f32_32x32x16_bf16(b1, qr[d0], p1, 0, 0, 0); }
}
__device__ __forceinline__ void exp_half(f32x16& p) {
#pragma unroll
    for (int r = 0; r < 16; ++r) p[r] = __builtin_amdgcn_exp2f(p[r]);
}
__device__ __forceinline__ void finish_sm(f32x16& p0, f32x16& p1, float& l_reg, bf16x8& pa0, bf16x8& pa1, bf16x8& pa2, bf16x8& pa3) {
    exp_half(p1);
    float ps = 0.f;
#pragma unroll
    for (int r = 0; r < 16; ++r) ps += p0[r];
#pragma unroll
    for (int r = 0; r < 16; ++r) ps += p1[r];
    l_reg += ps;
#define ATT_PK4(P, BASE, OUT) do { unsigned a0 = pk2(P[BASE + 0], P[BASE + 1]), a1 = pk2(P[BASE + 2], P[BASE + 3]);   \
    unsigned b0 = pk2(P[BASE + 4], P[BASE + 5]), b1 = pk2(P[BASE + 6], P[BASE + 7]);                              \
    auto r0 = __builtin_amdgcn_permlane32_swap(a0, b0, false, false); auto r1 = __builtin_amdgcn_permlane32_swap(a1, b1, false, false); \
    u32x4 w = {r0[0], r1[0], r0[1], r1[1]}; OUT = __builtin_bit_cast(bf16x8, w); } while (0)
    ATT_PK4(p0, 0, pa0); ATT_PK4(p0, 8, pa1); ATT_PK4(p1, 0, pa2); ATT_PK4(p1, 8, pa3);
#undef ATT_PK4
}

__device__ __forceinline__ void attn_unit(LAS unsigned char* lds, const bf16_t* __restrict__ Qh, const bf16_t* __restrict__ Kh, const bf16_t* __restrict__ Vh,
                                          int Sq, int Sk, int q0, bf16_t* __restrict__ outp, float lam, float negref, const float* __restrict__ subg) {
    const int tid = threadIdx.x, wid = __builtin_amdgcn_readfirstlane(tid >> 6), lane = tid & 63, r32 = lane & 31, hi = lane >> 5;
    const int comp = wid >> 2, qs = wid & 3;
    LAS unsigned char* V_lds = lds + V_OFF; LAS unsigned char* K_lds = lds + K_OFF;
    LAS float* wsf = (LAS float*)(lds + ATT_WSC_OFF) + wid * 64;
    bf16x8 qr[4];
    { const bf16_t* Qw = Qh + ((size_t)comp * Sq + q0 + qs * 32 + r32) * 64 + hi * 8;
#pragma unroll
      for (int d0 = 0; d0 < 4; ++d0) qr[d0] = *(const bf16x8*)(Qw + d0 * 16); }
    const int krow = tid >> 3, kcb = (tid & 7) * 16, kst = ATT_KSWZ(krow, kcb);
    const int sr = tid >> 4, sc = (tid & 15) * 8, vst0 = v_st(sr, sc), vst1 = v_st(32 + sr, sc);
    const bf16_t* Kg0 = Kh + tid * 8; const bf16_t* Kg1 = Kh + (size_t)Sk * 64 + tid * 8;
    const bf16_t* Vg0 = Vh + (size_t)sr * 128 + sc; const bf16_t* Vg1 = Vh + (size_t)(32 + sr) * 128 + sc;
    const int vb0 = (int)(unsigned)(uintptr_t)V_lds + v_rd_base(lane);
    const LAS unsigned char* Kc = K_lds + comp * 8192;
    bf16x8 sE_k0, sE_k1, sE_v0, sE_v1;
#define ATT_SLOAD(S, j) do { S##_k0 = *(const bf16x8*)(Kg0 + (size_t)(j) * 4096); S##_k1 = *(const bf16x8*)(Kg1 + (size_t)(j) * 4096); \
    S##_v0 = *(const bf16x8*)(Vg0 + (size_t)(j) * 8192); S##_v1 = *(const bf16x8*)(Vg1 + (size_t)(j) * 8192); } while (0)
#define ATT_SWRITE(b, S) do { *(LAS bf16x8*)(V_lds + (b) * 16384 + vst0) = S##_v0; *(LAS bf16x8*)(V_lds + (b) * 16384 + vst1) = S##_v1; \
    *(LAS bf16x8*)(K_lds + (b) * 16384 + kst) = S##_k0; *(LAS bf16x8*)(K_lds + (b) * 16384 + 8192 + kst) = S##_k1; } while (0)
#define ATT_SWAIT() asm volatile("s_waitcnt vmcnt(0)" ::: "memory")
    float l_reg = 0.f; f32x16 o[4];
#pragma unroll
    for (int d = 0; d < 4; ++d)
#pragma unroll
        for (int r = 0; r < 16; ++r) o[d][r] = 0.f;
    f32x16 pA0, pA1, pB0, pB1; bf16x8 pa0, pa1, pa2, pa3; const int NT = Sk / 64;
    ATT_SLOAD(sE, 0); asm volatile("s_waitcnt vmcnt(0)" ::: "memory"); ATT_SWRITE(0, sE); __syncthreads();
    qkt(pA0, pA1, Kc, qr, negref, r32, hi); exp_half(pA0);
    ATT_SLOAD(sE, 1);
    ATT_SWAIT(); ATT_SWRITE(1, sE); __syncthreads();
    for (int j = 1; j + 1 < NT; j += 2) {
        ATT_SBAR(); qkt(pB0, pB1, Kc + 16384, qr, negref, r32, hi);
        finish_sm(pA0, pA1, l_reg, pa0, pa1, pa2, pa3); ATT_SBAR();
        ATT_SLOAD(sE, j + 1); ATT_SBAR();
        pv_all(o, vb0, pa0, pa1, pa2, pa3); exp_half(pB0);
        __syncthreads(); ATT_SWAIT(); ATT_SWRITE(0, sE);
        __syncthreads();
        ATT_SBAR(); qkt(pA0, pA1, Kc, qr, negref, r32, hi);
        finish_sm(pB0, pB1, l_reg, pa0, pa1, pa2, pa3); ATT_SBAR();
        ATT_SLOAD(sE, j + 2); ATT_SBAR();
        pv_all(o, vb0 + 16384, pa0, pa1, pa2, pa3); exp_half(pA0);
        __syncthreads(); ATT_SWAIT(); ATT_SWRITE(1, sE);
        __syncthreads();
    }
    ATT_SBAR(); qkt(pB0, pB1, Kc + 16384, qr, negref, r32, hi);
    finish_sm(pA0, pA1, l_reg, pa0, pa1, pa2, pa3); ATT_SBAR();
    pv_all(o, vb0, pa0, pa1, pa2, pa3); exp_half(pB0);
    finish_sm(pB0, pB1, l_reg, pa0, pa1, pa2, pa3); ATT_SBAR();
    pv_all(o, vb0 + 16384, pa0, pa1, pa2, pa3);
#undef ATT_SLOAD
#undef ATT_SWRITE
#undef ATT_SWAIT
    { auto rr = __builtin_amdgcn_permlane32_swap(__float_as_uint(l_reg), __float_as_uint(l_reg), false, false); l_reg = __uint_as_float(rr[0]) + __uint_as_float(rr[1]); }
    int lz = lane; asm volatile("" : "+v"(lz));
    const int r32e = lz & 31, hie = lz >> 5;
    if (hie == 0) wsf[r32e] = l_reg;
    LDS_WAIT();
    float rli[16];
#pragma unroll
    for (int r = 0; r < 16; ++r) rli[r] = 1.0f / wsf[(r & 3) + 8 * (r >> 2) + 4 * hie];
    LAS float* ex = (LAS float*)(lds + EX_OFF) + qs * 4096;
    LAS float* exl = ex + lz;
    if (comp == 1) {
#pragma unroll
        for (int d0 = 0; d0 < 4; ++d0)
#pragma unroll
            for (int r = 0; r < 16; ++r) exl[(d0 * 16 + r) * 64] = o[d0][r] * rli[r];
    }
    __syncthreads();
    if (comp == 0) {
#pragma unroll
        for (int d0 = 0; d0 < 4; ++d0)
#pragma unroll
            for (int r = 0; r < 16; ++r) o[d0][r] = o[d0][r] * rli[r] - lam * exl[(d0 * 16 + r) * 64];
        LDS_WAIT(); asm volatile("" ::: "memory");
        LAS float* wb[4];
#pragma unroll
        for (int q = 0; q < 4; ++q) { const int rq = q + 4 * hie; wb[q] = ex + rq * 128 + (r32e ^ (rq << 2)); }
#pragma unroll
        for (int d0 = 0; d0 < 4; ++d0)
#pragma unroll
            for (int r = 0; r < 16; ++r) wb[r & 3][(r >> 2) * 1024 + d0 * 32] = o[d0][r];
        LDS_WAIT(); asm volatile("" ::: "memory");
        const int row2 = lz >> 1, half = lz & 1, x3 = (row2 & 7) << 2;
        const LAS float* rb = ex + row2 * 128 + 64 * half;
        f32x4 v[16]; float ss = 0.f;
#pragma unroll
        for (int i = 0; i < 16; ++i) { v[i] = *(const LAS f32x4*)(rb + ((4 * i) ^ x3)); ss += (v[i][0] * v[i][0] + v[i][1] * v[i][1]) + (v[i][2] * v[i][2] + v[i][3] * v[i][3]); }
        ss += __shfl_xor(ss, 1);
        const float rinv = rsqrtf(ss * (1.0f / 128.0f) + EPS) * ONE_M_LAMINIT;
        bf16_t* orow = outp + (size_t)(q0 + qs * 32 + row2) * KOUT + 64 * half;
        const float* sg = subg + 64 * half;
#pragma unroll
        for (int i = 0; i < 8; ++i) { const f32x4 g0 = *(const f32x4*)(sg + 8 * i), g1 = *(const f32x4*)(sg + 8 * i + 4); const f32x4 a = v[2 * i] * rinv * g0, b = v[2 * i + 1] * rinv * g1;
            u32x4 w; w.x = pk2(a[0], a[1]); w.y = pk2(a[2], a[3]); w.z = pk2(b[0], b[1]); w.w = pk2(b[2], b[3]); *(u32x4*)(orow + 8 * i) = w; }
    }
}
#undef ATT_KSWZ
#undef ATT_SBAR
}
struct Params {
    const float *x_p, *x_s, *cache_k, *cache_v, *c, *c_ctx, *n1, *n2, *w_ada, *b_ada, *w_in, *qg, *kg, *lq1, *lk1, *lq2, *lk2, *subg, *w_out, *w_gate, *w_up, *conv_w, *conv_b, *w_down;
    float* out; unsigned char* ws; int ph_lo, ph_hi, li, pad;
};
__device__ __forceinline__ int invperm32(int c) { return 16 * ((c >> 2) & 1) + 4 * (c >> 3) + (c & 3); }
__device__ __forceinline__ int rowperm(int n) { return (n & ~31) | invperm32(n & 31); }
__device__ __forceinline__ const float* xrow_ptr(const Params& P, int m) { return m < NTOK_P ? P.x_p + (size_t)m * DM : P.x_s + (size_t)(m - NTOK_P) * DM; }
__device__ __forceinline__ int modrow_of_tile(int pm) { return pm < 16 ? 0 : 1 + ((pm - 16) >> 2); }

template <int NC> __device__ __forceinline__ void gemv9_slab(const LAS float* vec, LAS float* red, const float* __restrict__ W, int ldw, int c0, const float* __restrict__ bias, float* __restrict__ out, int ldo, int oc0, int tid) {
    constexpr int NCG = NC / 4, KPAR = 512 / NCG, KP = KPAR + 1;
    const int cg = tid % NCG, ks = tid / NCG;
    float a[9][4];
#pragma unroll
    for (int j = 0; j < 9; ++j)
#pragma unroll
        for (int e = 0; e < 4; ++e) a[j][e] = 0.f;
    if (ks < KPAR) {
#pragma unroll 4
        for (int k = ks; k < 1024; k += KPAR) {
            const f32x4 w = *(const f32x4*)(W + (size_t)k * ldw + c0 + 4 * cg);
#pragma unroll
            for (int j = 0; j < 9; ++j) { const float v = vec[j * 1024 + k]; a[j][0] += v * w[0]; a[j][1] += v * w[1]; a[j][2] += v * w[2]; a[j][3] += v * w[3]; }
        }
#pragma unroll
        for (int j = 0; j < 9; ++j)
#pragma unroll
            for (int e = 0; e < 4; ++e) red[(j * NC + cg * 4 + e) * KP + ks] = a[j][e];
    }
    __syncthreads();
    if (tid < 9 * NC) { float s = 0.f; for (int q = 0; q < KPAR; ++q) s += red[tid * KP + q]; const int j = tid / NC, c = tid % NC; out[(size_t)j * ldo + oc0 + c] = s + (bias ? bias[oc0 + c] : 0.f); }
    __syncthreads();
}
template <class DestRow>
__device__ __forceinline__ void transpose_item(const float* __restrict__ W, int ldw, int k0, int n0, bf16_t* __restrict__ WT, int ldt, int kd0, DestRow dest, LAS float* scr, int lane) {
#pragma unroll 8
    for (int i = 0; i < 32; ++i) { const int kk = 2 * i + (lane >> 5); scr[kk * 33 + (lane & 31)] = W[(size_t)(k0 + kk) * ldw + n0 + (lane & 31)]; }
    LDS_WAIT(); asm volatile("" ::: "memory");
    const int c = lane & 7;
#pragma unroll
    for (int j = 0; j < 4; ++j) { const int n = (lane >> 3) + 8 * j; const LAS float* s = scr + (8 * c) * 33 + n;
        u32x4 o; o.x = pk2(s[0 * 33], s[1 * 33]); o.y = pk2(s[2 * 33], s[3 * 33]); o.z = pk2(s[4 * 33], s[5 * 33]); o.w = pk2(s[6 * 33], s[7 * 33]);
        *(u32x4*)(WT + (size_t)dest(n0 + n) * ldt + kd0 + 8 * c) = o; }
    LDS_WAIT(); asm volatile("" ::: "memory");
}
struct DestIn { __device__ __forceinline__ int operator()(int n) const { const int tile = n >> 8, tc = n & 255; int p;
    if (tile == 0) p = tc; else if (tile <= 6) p = 128 * ((tc >> 5) & 1) + 32 * (tc >> 6) + (tc & 31); else p = rowperm(tc); return tile * 256 + p; } };
struct DestPerm { __device__ __forceinline__ int operator()(int n) const { return rowperm(n); } };
struct DestGU { int up; __device__ __forceinline__ int operator()(int f) const { return (f >> 7) * 256 + up * 128 + rowperm(f & 127); } };
__device__ __forceinline__ void fout_item(const float* __restrict__ w_out, bf16_t* __restrict__ WT, int h, int nb, LAS float* scr, int lane) {
#pragma unroll
    for (int i = 0; i < 16; ++i) { const int d = 4 * i + (lane >> 4), j = lane & 15; scr[d * 17 + j] = w_out[(size_t)(64 * h + d) * DM + 16 * nb + j]; }
    LAS float* ctab = scr + 1088; LAS float* stab = scr + 1152;
    ctab[lane] = __builtin_amdgcn_cosf((float)lane * (1.0f / 64.0f)); stab[lane] = __builtin_amdgcn_sinf((float)lane * (1.0f / 64.0f));
    LDS_WAIT(); asm volatile("" ::: "memory");
    float ac[16], as_[16];
#pragma unroll
    for (int j = 0; j < 16; ++j) { ac[j] = 0.f; as_[j] = 0.f; }
#pragma unroll 2
    for (int d = 0; d < 64; ++d) { const int idx = (d * lane) & 63; const float cv = ctab[idx], sv = stab[idx];
#pragma unroll
        for (int j = 0; j < 16; ++j) { const float w = scr[d * 17 + j]; ac[j] += cv * w; as_[j] += sv * w; } }
#pragma unroll
    for (int j = 0; j < 16; ++j) { const int row = rowperm(16 * nb + j);
        WT[(size_t)row * KOUT + 64 * h + lane] = f2bf(ac[j] * 0.125f); WT[(size_t)row * KOUT + 256 + 64 * h + lane] = f2bf(-as_[j] * 0.125f); }
    LDS_WAIT(); asm volatile("" ::: "memory");
}

constexpr int I_TIN = 16 * 80, I_TOUT = 12 * 32, I_TG = 16 * 88, I_TU = 16 * 88, I_TDN = 44 * 32, I_FOUT = 4 * 64, I_CK = 3072, I_CV = 3072, I_DFTS = 4096, I_DFTP = 256, I_ROPE = 1;
constexpr int P0_ITEMS = I_TIN + I_TOUT + I_TG + I_TU + I_TDN + I_FOUT + I_CK + I_CV + I_DFTS + I_DFTP + I_ROPE;
__device__ __forceinline__ void p0_prep(const Params& P, LAS unsigned char* lds, int tid, int lane, int wave, int vcu, int G) {
    unsigned char* ws = P.ws;
    LAS float* vec = (LAS float*)lds; LAS float* red = (LAS float*)(lds + 36864);
    for (int i = tid; i < 9 * 1024; i += 512) { const int j = i >> 10, k = i & 1023; const float x = (j == 0) ? P.c_ctx[k] : P.c[(j - 1) * 1024 + k]; vec[i] = x / (1.0f + expf(-x)); }
    __syncthreads();
    for (int s = blockIdx.x; s < NADA / 24; s += G) gemv9_slab<24>(vec, red, P.w_ada, NADA, 24 * s, P.b_ada, (float*)(ws + WS_ADA), NADA, 24 * s, tid);
    __syncthreads();
    LAS float* scr = (LAS float*)(lds + wave * 9216);
    bf16_t* Wt_in = (bf16_t*)(ws + WS_WIN); bf16_t* Wt_out = (bf16_t*)(ws + WS_WOUT); bf16_t* Wt_gu = (bf16_t*)(ws + WS_WGU); bf16_t* Wt_dn = (bf16_t*)(ws + WS_WDN);
    const int gw = vcu * NWAVES + wave, NGW = G * NWAVES;
    for (int it = gw; it < P0_ITEMS; it += NGW) {
        int r = it;
        if (r < I_TIN) { transpose_item(P.w_in, DIN, 64 * (r / 80), 32 * (r % 80), Wt_in, DM, 64 * (r / 80), DestIn{}, scr, lane); continue; } r -= I_TIN;
        if (r < I_TOUT) { const int kb = r >> 5, nb = r & 31; transpose_item(P.w_out, DM, 256 + 64 * kb, 32 * nb, Wt_out, KOUT, 512 + 64 * kb, DestPerm{}, scr, lane); continue; } r -= I_TOUT;
        if (r < I_TG) { transpose_item(P.w_gate, DFF, 64 * (r / 88), 32 * (r % 88), Wt_gu, DM, 64 * (r / 88), DestGU{0}, scr, lane); continue; } r -= I_TG;
        if (r < I_TU) { transpose_item(P.w_up, DFF, 64 * (r / 88), 32 * (r % 88), Wt_gu, DM, 64 * (r / 88), DestGU{1}, scr, lane); continue; } r -= I_TU;
        if (r < I_TDN) { const int kb = r >> 5, nb = r & 31; transpose_item(P.w_down, DM, 64 * kb, 32 * nb, Wt_dn, DFF, 64 * kb, DestPerm{}, scr, lane); continue; } r -= I_TDN;
        if (r < I_FOUT) { fout_item(P.w_out, Wt_out, r >> 6, r & 63, scr, lane); continue; } r -= I_FOUT;
        if (r < I_CK) {
            bf16_t* Ks = (bf16_t*)(ws + WS_K_S); float mx = 0.f;
#pragma unroll
            for (int j = 0; j < 4; ++j) { const int q4 = r * 256 + j * 64 + lane, e = q4 * 4; const f32x4 x = *(const f32x4*)(P.cache_k + e);
                const int d = e & 63, cc = (e >> 6) & 1, p = (e >> 7) & 511, bh = e >> 16;
                u32x2 w; w.x = pk2(x[0], x[1]); w.y = pk2(x[2], x[3]); *(u32x2*)(Ks + ((size_t)(bh * 2 + cc) * SKS + 1024 + p) * 64 + d) = w;
                float ss = (x[0] * x[0] + x[1] * x[1]) + (x[2] * x[2] + x[3] * x[3]);
                ss += __shfl_xor(ss, 1); ss += __shfl_xor(ss, 2); ss += __shfl_xor(ss, 4); ss += __shfl_xor(ss, 8); mx = fmaxf(mx, ss); }
            mx = wave_max(mx);
            if (lane == 0) atomicMax((unsigned*)(ws + WS_CTL) + CW_KMAX, __float_as_uint(mx));
            continue; } r -= I_CK;
        if (r < I_CV) {
            bf16_t* Vs = (bf16_t*)(ws + WS_V_S);
#pragma unroll
            for (int j = 0; j < 4; ++j) { const int q4 = r * 256 + j * 64 + lane, e = q4 * 4; const f32x4 x = *(const f32x4*)(P.cache_v + e);
                const int dv = e & 127, p = (e >> 7) & 511, bh = e >> 16;
                u32x2 w; w.x = pk2(x[0], x[1]); w.y = pk2(x[2], x[3]); *(u32x2*)(Vs + ((size_t)bh * SKS + 1024 + p) * 128 + dv) = w; }
            continue; } r -= I_CV;
        if (r < I_DFTS + I_DFTP) {
            const bool smp = r < I_DFTS; const int lg = smp ? 10 : 8, S = 1 << lg; const int item = smp ? r : r - I_DFTS; bf16_t* Dm = (bf16_t*)(ws + (smp ? WS_DFTS : WS_DFTP));
            const float sc = smp ? 0.03125f : 0.0625f, invS = 1.0f / (float)S; const int idx0 = item * 512 + lane * 8, f = idx0 >> lg, s0 = idx0 & (S - 1), kf = f & (S - 1); const bool isSin = f >= S;
            float v[8];
#pragma unroll
            for (int i = 0; i < 8; ++i) { const float fr = (float)((kf * (s0 + i)) & (S - 1)) * invS; v[i] = (isSin ? __builtin_amdgcn_sinf(fr) : __builtin_amdgcn_cosf(fr)) * sc; }
            u32x4 w; w.x = pk2(v[0], v[1]); w.y = pk2(v[2], v[3]); w.z = pk2(v[4], v[5]); w.w = pk2(v[6], v[7]); *(u32x4*)(Dm + idx0) = w;
            continue; } r -= I_DFTS + I_DFTP;
        {
            f32x2* T = (f32x2*)(ws + WS_ROPE);
#pragma unroll
            for (int j = 0; j < 16; ++j) { const int ent = j * 64 + lane, pos = ent >> 4, i = ent & 15; const float inv = powf(10000.0f, -(float)i * (1.0f / 16.0f)); const float ang = (float)pos * inv, rev = ang * 0.15915494309189535f;
                T[ent] = (f32x2){__builtin_amdgcn_cosf(rev), __builtin_amdgcn_sinf(rev)}; }
        }
    }
}

__device__ __forceinline__ void p1_norm(const Params& P, LAS unsigned char* lds, int tid, int lane, int wave, int vcu, int G) {
    unsigned char* ws = P.ws; const float* ada = (const float*)(ws + WS_ADA);
    LAS float* vec = (LAS float*)lds; LAS float* red = (LAS float*)(lds + 36864);
    for (int i = tid; i < 9 * 1024; i += 512) { const int j = i >> 10, k = i & 1023; vec[i] = ada[(size_t)j * NADA + 3072 + k]; }
    __syncthreads();
    for (int s = blockIdx.x; s < 352; s += G) { const int mat = s / 176, c0 = (s % 176) * 16;
        gemv9_slab<16>(vec, red, mat ? P.w_up : P.w_gate, DFF, c0, nullptr, (float*)(ws + WS_BIAS2), NGU, mat * DFF + c0, tid); }
    bf16_t* Hb = (bf16_t*)(ws + WS_H);
    const int gw = vcu * NWAVES + wave, NGW = G * NWAVES;
    for (int m = gw; m < NTOK; m += NGW) {
        const int mr = m < NTOK_P ? 0 : 1 + ((m - NTOK_P) >> 10);
        const f32x4* xr = (const f32x4*)xrow_ptr(P, m) + lane;
        f32x4 v[4]; float s = 0.f;
#pragma unroll
        for (int j = 0; j < 4; ++j) { v[j] = xr[64 * j]; s += (v[j][0] * v[j][0] + v[j][1] * v[j][1]) + (v[j][2] * v[j][2] + v[j][3] * v[j][3]); }
        const float rstd = rsqrtf(wave_sum(s) * (1.0f / DM) + EPS);
        const f32x4* g1 = (const f32x4*)P.n1 + lane; const f32x4* sh = (const f32x4*)(ada + (size_t)mr * NADA) + lane; const f32x4* scl = (const f32x4*)(ada + (size_t)mr * NADA + 1024) + lane;
        u32x2* o8 = (u32x2*)(Hb + (size_t)m * DM) + lane;
#pragma unroll
        for (int j = 0; j < 4; ++j) { const f32x4 hv = v[j] * rstd * g1[64 * j] * (scl[64 * j] + 1.0f) + sh[64 * j]; u32x2 w; w.x = pk2(hv[0], hv[1]); w.y = pk2(hv[2], hv[3]); o8[64 * j] = w; }
    }
}

using pg8::Unit;
struct EpiInProj {
    static constexpr bool PERM = false, AFTER_DRAIN = false;
    unsigned char* ws; float* newk; float* newv; const float* qg; const float* kg;
    __device__ __forceinline__ void operator()(const f32x4 (&acc)[2][2][4][2], const Unit& u, int wr, int wc, int fr_, int fq_) const {
        int fr = fr_, fq = fq_; asm volatile("" : "+v"(fr), "+v"(fq));
        const bool prompt = u.pm < 16; const int b = prompt ? u.pm : (u.pm - 16) >> 2; const int s0 = prompt ? 0 : ((u.pm - 16) & 3) * 256; const int S = prompt ? SP : SS, Sk = prompt ? SP : SKS;
        if (u.pn == 0) {
            bf16_t* base = (bf16_t*)(ws + (prompt ? WS_XFT_P : WS_XFT_S)) + (size_t)b * 256 * S;
#pragma unroll
            for (int ai = 0; ai < 2; ++ai)
#pragma unroll
                for (int m = 0; m < 4; ++m) { const int s = s0 + 128 * ai + 64 * wr + 16 * m + fr;
#pragma unroll
                    for (int bj = 0; bj < 2; ++bj)
#pragma unroll
                        for (int n = 0; n < 2; ++n)
#pragma unroll
                            for (int e = 0; e < 4; ++e) { const int ch = 128 * bj + 32 * wc + 16 * n + 4 * fq + e; base[(size_t)ch * S + s] = f2bf(acc[ai][bj][m][n][e]); } }
        } else if (u.pn <= 6) {
            const bool isq = u.pn <= 3; const int t = isq ? u.pn - 1 : u.pn - 4; const int head = 2 * t + (wc >> 1), comp = wc & 1;
            const float* gsrc = isq ? qg : kg; f32x4 g[2][2];
#pragma unroll
            for (int bj = 0; bj < 2; ++bj)
#pragma unroll
                for (int n = 0; n < 2; ++n) g[bj][n] = *(const f32x4*)(gsrc + 32 * bj + 16 * n + 4 * fq);
            bf16_t* dst = isq ? (bf16_t*)(ws + (prompt ? WS_Q_P : WS_Q_S)) + ((size_t)((b * NH + head) * 2 + comp) * S) * 64
                              : (bf16_t*)(ws + (prompt ? WS_K_P : WS_K_S)) + ((size_t)((b * NH + head) * 2 + comp) * Sk) * 64;
            const f32x2* rope = (const f32x2*)(ws + WS_ROPE);
#pragma unroll
            for (int ai = 0; ai < 2; ++ai)
#pragma unroll
                for (int m = 0; m < 4; ++m) { const int s = s0 + 128 * ai + 64 * wr + 16 * m + fr;
                    f32x4 v[2][2]; float ss = 0.f;
#pragma unroll
                    for (int bj = 0; bj < 2; ++bj)
#pragma unroll
                        for (int n = 0; n < 2; ++n) { v[bj][n] = acc[ai][bj][m][n]; ss += (v[bj][n][0] * v[bj][n][0] + v[bj][n][1] * v[bj][n][1]) + (v[bj][n][2] * v[bj][n][2] + v[bj][n][3] * v[bj][n][3]); }
                    ss += __shfl_xor(ss, 16); ss += __shfl_xor(ss, 32);
                    const float rinv = rsqrtf(ss * (1.0f / 64.0f) + EPS);
#pragma unroll
                    for (int bj = 0; bj < 2; ++bj)
#pragma unroll
                        for (int n = 0; n < 2; ++n) v[bj][n] = v[bj][n] * rinv * g[bj][n];
                    if (!prompt) {
#pragma unroll
                        for (int bj = 0; bj < 2; ++bj) { const int pos = bj == 0 ? (s >> 6) : (s & 63); const f32x4* tp = (const f32x4*)(rope + pos * 16 + 4 * fq); const f32x4 t0 = tp[0], t1 = tp[1];
                            const float cs[4] = {t0[0], t0[2], t1[0], t1[2]}, sn[4] = {t0[1], t0[3], t1[1], t1[3]};
#pragma unroll
                            for (int e = 0; e < 4; ++e) { const float x1 = v[bj][0][e], x2 = v[bj][1][e]; v[bj][0][e] = x1 * cs[e] - x2 * sn[e]; v[bj][1][e] = x2 * cs[e] + x1 * sn[e]; } }
                    }
                    if (!isq && prompt) { float* nk = newk + ((size_t)((b * NH + head) * SP + s) * 2 + comp) * 64 + 4 * fq;
#pragma unroll
                        for (int bj = 0; bj < 2; ++bj)
#pragma unroll
                            for (int n = 0; n < 2; ++n) *(f32x4*)(nk + 32 * bj + 16 * n) = v[bj][n]; }
                    const float osc = isq ? C2 : 1.0f; bf16_t* drow = dst + (size_t)s * 64 + 4 * fq;
#pragma unroll
                    for (int bj = 0; bj < 2; ++bj)
#pragma unroll
                        for (int n = 0; n < 2; ++n) { const f32x4 x = v[bj][n] * osc; u32x2 w; w.x = pk2(x[0], x[1]); w.y = pk2(x[2], x[3]); *(u32x2*)(drow + 32 * bj + 16 * n) = w; }
                }
        } else {
            const int t = u.pn - 7;
#pragma unroll
            for (int bj = 0; bj < 2; ++bj) { const int head = 2 * t + bj;
                bf16_t* dst = (bf16_t*)(ws + (prompt ? WS_V_P : WS_V_S)) + ((size_t)(b * NH + head) * Sk) * 128 + 32 * wc + 8 * fq;
                float* nv = newv + ((size_t)(b * NH + head) * SP) * 128 + 32 * wc + 8 * fq;
#pragma unroll
                for (int ai = 0; ai < 2; ++ai)
#pragma unroll
                    for (int m = 0; m < 4; ++m) { const int s = s0 + 128 * ai + 64 * wr + 16 * m + fr; const f32x4 a = acc[ai][bj][m][0], c = acc[ai][bj][m][1];
                        u32x4 w; w.x = pk2(a[0], a[1]); w.y = pk2(a[2], a[3]); w.z = pk2(c[0], c[1]); w.w = pk2(c[2], c[3]); *(u32x4*)(dst + (size_t)s * 128) = w;
                        if (prompt) { *(f32x4*)(nv + (size_t)s * 128) = a; *(f32x4*)(nv + (size_t)s * 128 + 4) = c; } } }
        }
    }
};
struct EpiFourier {
    static constexpr bool PERM = false, AFTER_DRAIN = false;
    bf16_t* mix; int S, tok0;
    __device__ __forceinline__ void operator()(const f32x4 (&acc)[2][2][4][2], const Unit& u, int wr, int wc, int fr_, int fq_) const {
        int fr = fr_, fq = fq_; asm volatile("" : "+v"(fr), "+v"(fq));
        const int f0 = u.pm * 256, part = f0 >= S ? 1 : 0; const int k0 = f0 - part * S;
#pragma unroll
        for (int ai = 0; ai < 2; ++ai)
#pragma unroll
            for (int m = 0; m < 4; ++m) { bf16_t* rowp = mix + (size_t)(tok0 + u.pn * S + k0 + 128 * ai + 64 * wr + 16 * m + fr) * KOUT + part * 256 + 32 * wc + 4 * fq;
#pragma unroll
                for (int bj = 0; bj < 2; ++bj)
#pragma unroll
                    for (int n = 0; n < 2; ++n) { const f32x4 x = acc[ai][bj][m][n]; u32x2 w; w.x = pk2(x[0], x[1]); w.y = pk2(x[2], x[3]); *(u32x2*)(rowp + 128 * bj + 16 * n) = w; } }
    }
};
struct EpiOut {
    static constexpr bool PERM = false, AFTER_DRAIN = false;
    Params P;
    __device__ __forceinline__ void operator()(const f32x4 (&acc)[2][2][4][2], const Unit& u, int wr, int wc, int fr_, int fq_) const {
        int fr = fr_, fq = fq_; asm volatile("" : "+v"(fr), "+v"(fq));
        const float* ada = (const float*)(P.ws + WS_ADA) + (size_t)modrow_of_tile(u.pm) * NADA; bf16_t* x1s = (bf16_t*)(P.ws + WS_H); float* ssq = (float*)(P.ws + WS_SSQ);
        const int c0 = u.pn * 256 + 32 * wc + 8 * fq;
        f32x4 g1[2][2], md[2][2];
#pragma unroll
        for (int bj = 0; bj < 2; ++bj)
#pragma unroll
            for (int n = 0; n < 2; ++n) { const int c = c0 + 128 * bj + 4 * n; g1[bj][n] = *(const f32x4*)(ada + 2048 + c); md[bj][n] = *(const f32x4*)(P.n2 + c) * (*(const f32x4*)(ada + 4096 + c) + 1.0f); }
#pragma unroll
        for (int ai = 0; ai < 2; ++ai)
#pragma unroll
            for (int m = 0; m < 4; ++m) { const int r = u.pm * 256 + 128 * ai + 64 * wr + 16 * m + fr; const float* xr = xrow_ptr(P, r) + c0; float* yr = P.out + (size_t)r * DM + c0; bf16_t* hr = x1s + (size_t)r * DM + c0;
                float ss = 0.f;
#pragma unroll
                for (int bj = 0; bj < 2; ++bj) { const f32x4 xa = *(const f32x4*)(xr + 128 * bj), xb = *(const f32x4*)(xr + 128 * bj + 4);
                    const f32x4 ya = xa + g1[bj][0] * acc[ai][bj][m][0], yb = xb + g1[bj][1] * acc[ai][bj][m][1];
                    *(f32x4*)(yr + 128 * bj) = ya; *(f32x4*)(yr + 128 * bj + 4) = yb;
                    ss += (ya[0] * ya[0] + ya[1] * ya[1]) + (ya[2] * ya[2] + ya[3] * ya[3]) + (yb[0] * yb[0] + yb[1] * yb[1]) + (yb[2] * yb[2] + yb[3] * yb[3]);
                    const f32x4 ha = ya * md[bj][0], hb = yb * md[bj][1]; u32x4 w; w.x = pk2(ha[0], ha[1]); w.y = pk2(ha[2], ha[3]); w.z = pk2(hb[0], hb[1]); w.w = pk2(hb[2], hb[3]); *(u32x4*)(hr + 128 * bj) = w; }
                ss += __shfl_xor(ss, 16); ss += __shfl_xor(ss, 32);
                if (fq == 0) ssq[(size_t)r * 16 + u.pn * 4 + wc] = ss; }
    }
};
struct EpiGU {
    static constexpr bool PERM = false, AFTER_DRAIN = false;
    unsigned char* ws;
    __device__ __forceinline__ void operator()(const f32x4 (&acc)[2][2][4][2], const Unit& u, int wr, int wc, int fr_, int fq_) const {
        int fr = fr_, fq = fq_; asm volatile("" : "+v"(fr), "+v"(fq));
        const float* b2 = (const float*)(ws + WS_BIAS2) + (size_t)modrow_of_tile(u.pm) * NGU; const float* ssq = (const float*)(ws + WS_SSQ);
        bf16_t* Gb = (bf16_t*)(ws + WS_G); bf16_t* Ub = (bf16_t*)(ws + WS_U);
        const int f0 = u.pn * 128 + 32 * wc + 8 * fq;
        const f32x4 bg0 = *(const f32x4*)(b2 + f0), bg1 = *(const f32x4*)(b2 + f0 + 4), bu0 = *(const f32x4*)(b2 + DFF + f0), bu1 = *(const f32x4*)(b2 + DFF + f0 + 4);
#pragma unroll
        for (int ai = 0; ai < 2; ++ai)
#pragma unroll
            for (int m = 0; m < 4; ++m) { const int r = u.pm * 256 + 128 * ai + 64 * wr + 16 * m + fr; const f32x4* sp = (const f32x4*)(ssq + (size_t)r * 16);
                const f32x4 s0 = sp[0], s1 = sp[1], s2 = sp[2], s3 = sp[3];
                const float tot = ((s0[0] + s0[1]) + (s0[2] + s0[3])) + ((s1[0] + s1[1]) + (s1[2] + s1[3])) + ((s2[0] + s2[1]) + (s2[2] + s2[3])) + ((s3[0] + s3[1]) + (s3[2] + s3[3]));
                const float rstd = rsqrtf(tot * (1.0f / DM) + EPS);
                const f32x4 ga = acc[ai][0][m][0] * rstd + bg0, gb = acc[ai][0][m][1] * rstd + bg1, ua = acc[ai][1][m][0] * rstd + bu0, ub = acc[ai][1][m][1] * rstd + bu1;
                u32x4 w; w.x = pk2(ga[0], ga[1]); w.y = pk2(ga[2], ga[3]); w.z = pk2(gb[0], gb[1]); w.w = pk2(gb[2], gb[3]); *(u32x4*)(Gb + (size_t)r * DFF + f0) = w;
                u32x4 z; z.x = pk2(ua[0], ua[1]); z.y = pk2(ua[2], ua[3]); z.z = pk2(ub[0], ub[1]); z.w = pk2(ub[2], ub[3]); *(u32x4*)(Ub + (size_t)r * DFF + f0) = z; }
    }
};
struct EpiDown {
    static constexpr bool PERM = false, AFTER_DRAIN = false;
    unsigned char* ws; float* out;
    __device__ __forceinline__ void operator()(const f32x4 (&acc)[2][2][4][2], const Unit& u, int wr, int wc, int fr_, int fq_) const {
        int fr = fr_, fq = fq_; asm volatile("" : "+v"(fr), "+v"(fq));
        const float* ada = (const float*)(ws + WS_ADA) + (size_t)modrow_of_tile(u.pm) * NADA;
        const int c0 = u.pn * 256 + 32 * wc + 8 * fq;
        f32x4 g2[2][2];
#pragma unroll
        for (int bj = 0; bj < 2; ++bj)
#pragma unroll
            for (int n = 0; n < 2; ++n) g2[bj][n] = *(const f32x4*)(ada + 5120 + c0 + 128 * bj + 4 * n);
#pragma unroll
        for (int ai = 0; ai < 2; ++ai)
#pragma unroll
            for (int m = 0; m < 4; ++m) { float* yr = out + (size_t)(u.pm * 256 + 128 * ai + 64 * wr + 16 * m + fr) * DM + c0;
#pragma unroll
                for (int bj = 0; bj < 2; ++bj)
#pragma unroll
                    for (int n = 0; n < 2; ++n) { f32x4* p = (f32x4*)(yr + 128 * bj + 4 * n); *p = *p + g2[bj][n] * acc[ai][bj][m][n]; } }
    }
};
struct OneUnitSched {
    int has; Unit u0;
    __device__ __forceinline__ bool next(int i, Unit& u) const { if (i > 0 || !has) return false; u = u0; return true; }
    __device__ __forceinline__ void a_ready(const Unit&) const {}
    __device__ __forceinline__ void done(const Unit&) const {}
};

__device__ __forceinline__ void p6_act(const Params& P, int tid, int G) {
    const bf16_t* Gb = (const bf16_t*)(P.ws + WS_G); bf16_t* Ub = (bf16_t*)(P.ws + WS_U);
    constexpr int CG = DFF / 8;
    const int rows_per = (NTOK + G - 1) / G;
    const int r_lo = blockIdx.x * rows_per, r_hi = (r_lo + rows_per < NTOK) ? r_lo + rows_per : NTOK;
    for (int it = r_lo * CG + tid; it < r_hi * CG; it += 512) {
        const int r = it / CG, f0 = (it % CG) * 8;
        const int sl = r < NTOK_P ? (r & 255) : ((r - NTOK_P) & 1023); const int last = r < NTOK_P ? 255 : 1023;
        const u32x4 zero = {0u, 0u, 0u, 0u};
        const u32x4 gm = *(const u32x4*)(Gb + (size_t)r * DFF + f0);
        const u32x4 gl = sl > 0 ? *(const u32x4*)(Gb + (size_t)(r - 1) * DFF + f0) : zero;
        const u32x4 gr = sl < last ? *(const u32x4*)(Gb + (size_t)(r + 1) * DFF + f0) : zero;
        const u32x4 uu = *(const u32x4*)(Ub + (size_t)r * DFF + f0);
        const f32x4 w0a = *(const f32x4*)(P.conv_w + f0), w0b = *(const f32x4*)(P.conv_w + f0 + 4), w1a = *(const f32x4*)(P.conv_w + DFF + f0), w1b = *(const f32x4*)(P.conv_w + DFF + f0 + 4);
        const f32x4 w2a = *(const f32x4*)(P.conv_w + 2 * DFF + f0), w2b = *(const f32x4*)(P.conv_w + 2 * DFF + f0 + 4), cba = *(const f32x4*)(P.conv_b + f0), cbb = *(const f32x4*)(P.conv_b + f0 + 4);
        float w0[8] = {w0a[0], w0a[1], w0a[2], w0a[3], w0b[0], w0b[1], w0b[2], w0b[3]}, w1[8] = {w1a[0], w1a[1], w1a[2], w1a[3], w1b[0], w1b[1], w1b[2], w1b[3]};
        float w2[8] = {w2a[0], w2a[1], w2a[2], w2a[3], w2b[0], w2b[1], w2b[2], w2b[3]}, cb[8] = {cba[0], cba[1], cba[2], cba[3], cbb[0], cbb[1], cbb[2], cbb[3]};
        float res[8];
#pragma unroll
        for (int i = 0; i < 8; ++i) { const unsigned sh = (i & 1) ? 0xffff0000u : 0u; const int wi = i >> 1;
            const float a = __uint_as_float((i & 1) ? (gl[wi] & sh) : (gl[wi] << 16)), b = __uint_as_float((i & 1) ? (gm[wi] & sh) : (gm[wi] << 16)), c = __uint_as_float((i & 1) ? (gr[wi] & sh) : (gr[wi] << 16));
            const float uv = __uint_as_float((i & 1) ? (uu[wi] & sh) : (uu[wi] << 16));
            const float x = a * w0[i] + b * w1[i] + c * w2[i] + cb[i];
            res[i] = x / (1.0f + __expf(-x)) * uv; }
        u32x4 o; o.x = pk2(res[0], res[1]); o.y = pk2(res[2], res[3]); o.z = pk2(res[4], res[5]); o.w = pk2(res[6], res[7]);
        *(u32x4*)(Ub + (size_t)r * DFF + f0) = o;
    }
}
constexpr int N_PHASES = 8;
constexpr int N_LAUNCHES = MK_N_LAUNCHES;
struct StridedSched {
    int n, first, stride, npm;
    __device__ __forceinline__ bool next(int i, Unit& u) const { const int idx = first + i * stride; if (idx >= n) return false; u.pm = idx % npm; u.pn = idx / npm; return true; }
    __device__ __forceinline__ void a_ready(const Unit&) const {}
    __device__ __forceinline__ void done(const Unit&) const {}
};
__device__ __forceinline__ bool attn_next(int vcu, int G, int i, int& kind, int& idx) {
    if (G == 256) {
        if (vcu < 128) { if (i >= 2) return false; kind = 0; idx = 2 * vcu + i; return true; }
        const int v = vcu - 128;
        if (i == 0) { kind = 0; idx = 256 + v; return true; }
        if (v < 64 || i > 3) return false;
        kind = 1; idx = 3 * (v - 64) + i - 1; return true;
    }
    const int l = vcu + i * G; if (l >= 576) return false;
    if (l < 384) { kind = 0; idx = l; } else { kind = 1; idx = l - 384; }
    return true;
}
__global__ void __launch_bounds__(NWAVES * 64, 2) mk_fwd(Params P) {
    extern __shared__ __attribute__((aligned(16))) unsigned char lds_raw[];
    LAS unsigned char* lds = (LAS unsigned char*)lds_raw;
    const int tid = threadIdx.x, lane = tid & 63, wave = __builtin_amdgcn_readfirstlane(tid >> 6);
    const int G = gridDim.x, bx = blockIdx.x, vcu = (G % 8 == 0) ? (bx % 8) * (G / 8) + bx / 8 : bx;
    volatile LAS unsigned* MISC = (volatile LAS unsigned*)(lds + MISC_OFF);
    unsigned char* ws = P.ws;
    unsigned* ctl = (unsigned*)(ws + WS_CTL);
    for (int u = tid; u < (LDS_BYTES - LDSCTL_OFF) / 4; u += NWAVES * 64) ((LAS unsigned*)(lds + LDSCTL_OFF))[u] = 0u;
    __syncthreads();
    XcdBarrier bar; bar.bar = ctl + CW_BAR; bar.x = 0; bar.st = nullptr;
    if (N_LAUNCHES == 1) bar = xcd_barrier_post(ctl + CW_BAR, MISC + 8);
#define GRID_BAR() do { if (N_LAUNCHES == 1) xcd_barrier(bar); } while (0)
    const int lo = P.ph_lo, hi = P.ph_hi;
#ifndef PHASE_MASK
#define PHASE_MASK 0xff
#endif
#define IN(k) (((PHASE_MASK >> (k)) & 1) && lo <= (k) && (k) < hi)
#define BOTH(k) (IN(k) && IN((k) + 1))

    if (IN(0)) { p0_prep(P, lds, tid, lane, wave, vcu, G); if (BOTH(0)) GRID_BAR(); }
    if (IN(1)) { p1_norm(P, lds, tid, lane, wave, vcu, G); if (BOTH(1)) GRID_BAR(); }
    if (IN(2)) {
        pg8::Gemm g{(const bf16_t*)(ws + WS_H), (const bf16_t*)(ws + WS_WIN), NTOK, DIN, DM}; pg8::StaticOrder S; S.init(NTOK, DIN, G, bx);
        EpiInProj E{ws, P.out + (size_t)NTOK * DM, P.out + (size_t)NTOK * DM + (size_t)16 * NH * SP * 128, P.qg, P.kg};
        pg8::gemm_phase<EpiInProj, pg8::StaticOrder, true, true>(lds + RING_OFF, g, S, E);
        if (BOTH(2)) GRID_BAR();
    }
    if (IN(3)) {
        float lam, negref;
        { const float a = wave_sum(P.lq1[lane] * P.lk1[lane]), b2 = wave_sum(P.lq2[lane] * P.lk2[lane]); lam = expf(a) - expf(b2) + LAM_INIT;
          const float gq = wave_max(fabsf(P.qg[lane])), gk = wave_max(fabsf(P.kg[lane]));
          const float kmax2 = __uint_as_float(__hip_atomic_load(ctl + CW_KMAX, RLX_AGENT)); const float kmax = fmaxf(8.0f * gk, sqrtf(kmax2));
          negref = -(C2 * 8.0f * gq * kmax * 1.01f + 0.25f); }
#ifndef ATTN_OFF
        for (int i = 0; ; ++i) {
            int kind, idx; if (!attn_next(vcu, G, i, kind, idx)) break;
            const int bh = kind ? idx >> 1 : idx >> 3, qb = kind ? idx & 1 : idx & 7, b = bh / NH, h = bh - b * NH;
            const int Sq = kind ? SP : SS, Sk = kind ? SP : SKS;
            const bf16_t* Qh = (const bf16_t*)(ws + (kind ? WS_Q_P : WS_Q_S)) + (size_t)bh * 2 * Sq * 64;
            const bf16_t* Kh = (const bf16_t*)(ws + (kind ? WS_K_P : WS_K_S)) + (size_t)bh * 2 * Sk * 64;
            const bf16_t* Vh = (const bf16_t*)(ws + (kind ? WS_V_P : WS_V_S)) + (size_t)bh * Sk * 128;
            bf16_t* outp = (bf16_t*)(ws + WS_MIX) + (size_t)((kind ? 0 : NTOK_P) + b * Sq) * KOUT + 512 + h * 128;
            attn::attn_unit(lds, Qh, Kh, Vh, Sq, Sk, qb * 128, outp, lam, negref, P.subg);
        }
#endif
#ifndef FOURIER_OFF
        __syncthreads();
        { pg8::Gemm g{(const bf16_t*)(ws + WS_DFTS), (const bf16_t*)(ws + WS_XFT_S), 2048, 2048, SS};
          StridedSched S = (G == 256) ? StridedSched{64, (vcu >= 128 && vcu < 192) ? vcu - 128 : 64, 64, 8} : StridedSched{64, vcu, G, 8};
          EpiFourier E{(bf16_t*)(ws + WS_MIX), SS, NTOK_P};
          pg8::gemm_phase<EpiFourier, StridedSched, true, true>(lds + RING_OFF, g, S, E); }
        __syncthreads();
        { pg8::Gemm g{(const bf16_t*)(ws + WS_DFTP), (const bf16_t*)(ws + WS_XFT_P), 512, 4096, SP};
          StridedSched S = (G == 256) ? StridedSched{32, (vcu >= 192 && vcu < 224) ? vcu - 192 : 32, 32, 2} : StridedSched{32, vcu, G, 2};
          EpiFourier E{(bf16_t*)(ws + WS_MIX), SP, 0};
          pg8::gemm_phase<EpiFourier, StridedSched, true, true>(lds + RING_OFF, g, S, E); }
#endif
        if (BOTH(3)) GRID_BAR();
    }
    if (IN(4)) {
        pg8::Gemm g{(const bf16_t*)(ws + WS_MIX), (const bf16_t*)(ws + WS_WOUT), NTOK, DM, KOUT}; pg8::StaticOrder S; S.init(NTOK, DM, G, bx);
        EpiOut E{P};
        pg8::gemm_phase<EpiOut, pg8::StaticOrder, true, true>(lds + RING_OFF, g, S, E);
        if (BOTH(4)) GRID_BAR();
    }
    if (IN(5)) {
        pg8::Gemm g{(const bf16_t*)(ws + WS_H), (const bf16_t*)(ws + WS_WGU), NTOK, NGU, DM}; pg8::StaticOrder S; S.init(NTOK, NGU, G, bx);
        EpiGU E{ws};
        pg8::gemm_phase<EpiGU, pg8::StaticOrder, true, true>(lds + RING_OFF, g, S, E);
        if (BOTH(5)) GRID_BAR();
    }
    if (IN(6)) { p6_act(P, tid, G); if (BOTH(6)) GRID_BAR(); }
    if (IN(7)) {
        pg8::Gemm g{(const bf16_t*)(ws + WS_U), (const bf16_t*)(ws + WS_WDN), NTOK, DM, DFF}; pg8::StaticOrder S; S.init(NTOK, DM, G, bx);
        EpiDown E{ws, P.out};
        pg8::gemm_phase<EpiDown, pg8::StaticOrder, true, true>(lds + RING_OFF, g, S, E);
    }
#undef IN
#undef BOTH
#undef GRID_BAR
}

extern "C" void kernel_launch(void* const* d_in, const int* in_sizes, int n_in, void* d_out, int out_size, void* d_ws, size_t ws_size, hipStream_t stream) {
    static int ok = 0;
    if (ok == 0) {
        if (n_in != 24 || ws_size < WS_END) { fprintf(stderr, "kernel_launch: expected 24 inputs and >= %zu bytes of workspace; got %d, %zu\n", (size_t)WS_END, n_in, ws_size); ok = -1; return; }
        if (hipFuncSetAttribute((const void*)mk_fwd, hipFuncAttributeMaxDynamicSharedMemorySize, LDS_BYTES) != hipSuccess) { fprintf(stderr, "kernel_launch: hipFuncSetAttribute failed\n"); ok = -1; return; }
        int per_cu = 0;
        if (hipOccupancyMaxActiveBlocksPerMultiprocessor(&per_cu, (const void*)mk_fwd, NWAVES * 64, LDS_BYTES) != hipSuccess || per_cu < 1) fprintf(stderr, "kernel_launch: note: occupancy query reports %d workgroups per CU\n", per_cu);
        (void)hipGetLastError();
        ok = 1;
    }
    if (ok < 0) return;
    (void)hipMemsetAsync((char*)d_ws + WS_CTL, 0, CTL_ZERO_BYTES, stream);
    Params a{};
    const float** pp = (const float**)&a;
    for (int i = 0; i < 24; ++i) pp[i] = (const float*)d_in[i];
    a.out = (float*)d_out; a.ws = (unsigned char*)d_ws;
    for (int li = 0; li < N_LAUNCHES; ++li) {
        a.ph_lo = (N_LAUNCHES == 1) ? 0 : li; a.ph_hi = (N_LAUNCHES == 1) ? N_PHASES : li + 1; a.li = li; a.pad = 0;
        hipLaunchKernelGGL(mk_fwd, dim3(256), dim3(NWAVES * 64), LDS_BYTES, stream, a);
        const hipError_t le = hipPeekAtLastError();
        if (le != hipSuccess) { fprintf(stderr, "kernel_launch: launch %d failed: %s\n", li, hipGetErrorName(le)); break; }
    }
}
```

```cpp
#include <hip/hip_runtime.h>
#include <cstdio>
#include <cstdint>

#ifndef MK_N_LAUNCHES
#define MK_N_LAUNCHES 1
#endif
#define LAS __attribute__((address_space(3)))
#define GAS __attribute__((address_space(1)))
typedef unsigned short bf16_t;
typedef short bf16x8 __attribute__((ext_vector_type(8)));
typedef short s16x4 __attribute__((ext_vector_type(4)));
typedef float f32x2 __attribute__((ext_vector_type(2)));
typedef float f32x4 __attribute__((ext_vector_type(4)));
typedef float f32x16 __attribute__((ext_vector_type(16)));
typedef unsigned u32x2 __attribute__((ext_vector_type(2)));
typedef unsigned u32x4 __attribute__((ext_vector_type(4)));
typedef __bf16 bf16x2_t __attribute__((ext_vector_type(2)));
typedef GAS unsigned gu32;
#define RLX_AGENT __ATOMIC_RELAXED, __HIP_MEMORY_SCOPE_AGENT
#define LDS_WAIT() asm volatile("s_waitcnt lgkmcnt(0)" ::: "memory")
#define VM_WAIT() asm volatile("s_waitcnt vmcnt(0)" ::: "memory")
__device__ __forceinline__ unsigned pk2(float lo, float hi) { f32x2 v = {lo, hi}; bf16x2_t b = __builtin_convertvector(v, bf16x2_t); return __builtin_bit_cast(unsigned, b); }
__device__ __forceinline__ bf16_t f2bf(float x) { return (bf16_t)(pk2(x, 0.f) & 0xffffu); }
__device__ __forceinline__ float wave_sum(float v) {
#pragma unroll
    for (int o = 1; o < 64; o <<= 1) v += __shfl_xor(v, o);
    return v;
}
__device__ __forceinline__ float wave_max(float v) {
#pragma unroll
    for (int o = 1; o < 64; o <<= 1) v = fmaxf(v, __shfl_xor(v, o));
    return v;
}

constexpr int DM = 1024, NTOK = 12288, NTOK_P = 4096, NH = 6;
constexpr int SP = 256, SS = 1024, SKS = 1536, PAST = 512;
constexpr int DIN = 2560, DFF = 2816, KOUT = 1280, NGU = 5632, NADA = 6144;
constexpr float EPS = 1e-6f;
constexpr float C2 = 0.125f * 1.4426950408889634f;
constexpr float ONE_M_LAMINIT = 0.8f, LAM_INIT = 0.2f;

constexpr size_t MiB = 1u << 20;
constexpr size_t WS_CTL = 0, CTL_ZERO_BYTES = 1 * MiB;
constexpr size_t WS_ADA = 1 * MiB;
constexpr size_t WS_BIAS2 = 1 * MiB + 256 * 1024;
constexpr size_t WS_ROPE = 1 * MiB + 512 * 1024;
constexpr size_t WS_SSQ = 2 * MiB;
constexpr size_t WS_WIN = 3 * MiB;
constexpr size_t WS_WOUT = 8 * MiB;
constexpr size_t WS_WGU = 11 * MiB;
constexpr size_t WS_WDN = 22 * MiB;
constexpr size_t WS_DFTS = 28 * MiB;
constexpr size_t WS_DFTP = 32 * MiB;
constexpr size_t WS_H = 33 * MiB;
constexpr size_t WS_XFT_P = 58 * MiB, WS_XFT_S = 60 * MiB;
constexpr size_t WS_Q_P = 64 * MiB, WS_Q_S = 70 * MiB;
constexpr size_t WS_K_P = 82 * MiB, WS_K_S = 88 * MiB;
constexpr size_t WS_V_P = 106 * MiB, WS_V_S = 112 * MiB;
constexpr size_t WS_MIX = 130 * MiB;
constexpr size_t WS_G = 58 * MiB, WS_U = 124 * MiB;
constexpr size_t WS_END = 190 * MiB;
constexpr int CW_TMO = 0, CW_CODE = 1, CW_KMAX = 64, CW_BAR = 4096;

constexpr int RING_OFF = 0, RING_BYTES = 131072;
constexpr int ATT_WSC_OFF = RING_BYTES;
constexpr int LDSCTL_OFF = RING_BYTES + 2048, MISC_OFF = LDSCTL_OFF + 320;
constexpr int LDS_BYTES = 147456;
constexpr int NWAVES = 8;
namespace pg8 {
#define PG8_LAS __attribute__((address_space(3)))
typedef unsigned short bf16_t;
typedef short bf16x8 __attribute__((ext_vector_type(8)));
typedef float f32x4 __attribute__((ext_vector_type(4)));
typedef unsigned u32x4 __attribute__((ext_vector_type(4)));
constexpr int BM = 256, BK = 64, HALF = 128, HTB = HALF * BK * 2  , STAGE_BYTES = 8 * HTB, NXCD = 8, WGM = 8;

__host__ __device__ __forceinline__ int lds_byte(int r, int c) { const int st = (r >> 4) * 2 + (c >> 5), rr = r & 15, cc = c & 31, ob = rr * 64 + cc * 2; return st * 1024 + (ob ^ (((ob >> 9) & 1) << 5)); }
__host__ __device__ __forceinline__ void stage_rc(int b, int& R, int& C) { const int st = b / 1024, sb = b % 1024, swz = sb ^ (((sb >> 9) & 1) << 5); R = (st >> 1) * 16 + swz / 64; C = (st & 1) * 32 + (swz % 64) / 2; }
__host__ __device__ __forceinline__ int perm32(int rho) { const int n = rho >> 4, i = rho & 15; return 8 * (i >> 2) + 4 * n + (i & 3); }

struct Unit { int pm, pn; };
struct Gemm { const bf16_t* A; const bf16_t* Bt; int M, N, K; };

struct StaticOrder {
    int nM, nN, nwg, G, c;
    __host__ __device__ void init(int M, int N, int G_, int c_) { nM = M / BM; nN = N / BM; nwg = nM * nN; G = G_; c = c_; }
    __host__ __device__ bool next(int i, Unit& u) const {
        const long L = (long)i * G + c; if (L >= nwg) return false;
        int wgid = (int)L; { const int q = nwg / NXCD, r = nwg % NXCD, xcd = wgid % NXCD, off = wgid / NXCD; wgid = (xcd < r ? xcd * (q + 1) : r * (q + 1) + (xcd - r) * q) + off; }
        const int nig = WGM * nN, gid = wgid / nig, fm = gid * WGM, gsz = (nM - fm) < WGM ? (nM - fm) : WGM;
        u.pm = fm + ((wgid % nig) % gsz); u.pn = (wgid % nig) / gsz; return true;
    }
    __device__ __forceinline__ void a_ready(const Unit&) const {}
    __device__ __forceinline__ void done(const Unit&) const {}
};

__device__ __forceinline__ unsigned cvt_pk_bf16(float lo, float hi) { unsigned r; asm volatile("v_cvt_pk_bf16_f32 %0, %1, %2" : "=v"(r) : "v"(lo), "v"(hi)); return r; }
template <class Epi, class Sched, bool ALIGN_EPI = false, bool SP2 = false>
__device__ __forceinline__ void gemm_phase(PG8_LAS unsigned char* lds, const Gemm g, const Sched& S, const Epi& E) {
    const int tid = threadIdx.x, wid = __builtin_amdgcn_readfirstlane(tid >> 6), lane = tid & 63, wr = wid >> 2, wc = wid & 3, fr = lane & 15, fq = lane >> 4;
    const int K = g.K, nt = K / BK;
    unsigned voffA[2], voffB[2];
#pragma unroll
    for (int i = 0; i < 2; ++i) { int R, C; stage_rc(tid * 16 + i * 8192, R, C); const int Rb = Epi::PERM ? ((R & ~31) + perm32(R & 31)) : R;
        voffA[i] = (unsigned)(R * K + C) * 2u; voffB[i] = (unsigned)(Rb * K + C) * 2u; }
    const size_t kstep = (size_t)(BK * 2);
    const size_t hstep = (size_t)HALF * K * 2;
    const size_t tstep = 2 * hstep;
    const unsigned ldsw = (unsigned)wid * 1024u;
    const int aoff = lds_byte(wr * 64 + fr, fq * 8), boff = lds_byte(wc * 32 + fr, fq * 8);
#define PG8_SA(b, h) (((b) * 2 + (h)) * HTB)
#define PG8_SB(b, h) ((4 + (b) * 2 + (h)) * HTB)
#define PG8_STAGE(bufoff, gbase, voff) do { _Pragma("unroll") for (int _i = 0; _i < 2; ++_i) \
        __builtin_amdgcn_global_load_lds((const unsigned*)((const char*)(gbase) + (voff)[_i]), (PG8_LAS unsigned*)(lds + (bufoff) + ldsw + _i * 8192), 16, 0, 0); } while (0)
#define PG8_LDA(dst, b, h) do { _Pragma("unroll") for (int m = 0; m < 4; ++m) _Pragma("unroll") for (int k = 0; k < 2; ++k) dst[m][k] = *(const PG8_LAS bf16x8*)(lds + PG8_SA(b, h) + aoff + m * 2048 + k * 1024); } while (0)
#define PG8_LDB(dst, b, h) do { _Pragma("unroll") for (int n = 0; n < 2; ++n) _Pragma("unroll") for (int k = 0; k < 2; ++k) dst[n][k] = *(const PG8_LAS bf16x8*)(lds + PG8_SB(b, h) + boff + n * 2048 + k * 1024); } while (0)
#define PG8_MMA(ai, bj, At, Bt) do { __builtin_amdgcn_s_setprio(1); _Pragma("unroll") for (int m = 0; m < 4; ++m) _Pragma("unroll") for (int n = 0; n < 2; ++n) _Pragma("unroll") for (int k = 0; k < 2; ++k) \
        acc[ai][bj][m][n] = __builtin_amdgcn_mfma_f32_16x16x32_bf16(Bt[n][k], At[m][k], acc[ai][bj][m][n], 0, 0, 0); __builtin_amdgcn_s_setprio(0); } while (0)
#define PG8_WAIT_V(n) asm volatile("s_waitcnt vmcnt(" #n ")" ::: "memory")
#define PG8_WAIT_L(n) asm volatile("s_waitcnt lgkmcnt(" #n ")" ::: "memory")
#define PG8_BAR __builtin_amdgcn_s_barrier()
#define PG8_SCHED __builtin_amdgcn_sched_barrier(0)
    Unit cur, nxt; int ui = 0;
    if (!S.next(0, cur)) return;
    f32x4 acc[2][2][4][2];
#pragma unroll
    for (int a = 0; a < 2; ++a)
#pragma unroll
        for (int b = 0; b < 2; ++b)
#pragma unroll
            for (int m = 0; m < 4; ++m)
#pragma unroll
                for (int n = 0; n < 2; ++n) acc[a][b][m][n] = (f32x4){0.f, 0.f, 0.f, 0.f};
    bf16x8 At[4][2], B0[2][2], B1[2][2];
    const char* cA = (const char*)g.A + (size_t)cur.pm * tstep; const char* cB = (const char*)g.Bt + (size_t)cur.pn * tstep;
    S.a_ready(cur);
    if constexpr (SP2) {
        PG8_STAGE(PG8_SB(0, 0), cB, voffB); PG8_STAGE(PG8_SB(0, 1), cB + hstep, voffB); PG8_STAGE(PG8_SA(0, 0), cA, voffA); PG8_STAGE(PG8_SA(0, 1), cA + hstep, voffA);
        if (wr == 1) PG8_BAR;
        PG8_WAIT_V(2); PG8_BAR;
        PG8_STAGE(PG8_SB(1, 0), cB + kstep, voffB); PG8_STAGE(PG8_SA(1, 0), cA + kstep, voffA); PG8_STAGE(PG8_SB(1, 1), cB + hstep + kstep, voffB);
        PG8_WAIT_V(6); PG8_BAR;
    } else {
        PG8_STAGE(PG8_SB(0, 0), cB, voffB); PG8_STAGE(PG8_SA(0, 0), cA, voffA); PG8_STAGE(PG8_SB(0, 1), cB + hstep, voffB); PG8_STAGE(PG8_SA(0, 1), cA + hstep, voffA);
        if (wr == 1) PG8_BAR;
        PG8_WAIT_V(4); PG8_BAR;
        PG8_STAGE(PG8_SB(1, 0), cB + kstep, voffB); PG8_STAGE(PG8_SA(1, 0), cA + kstep, voffA); PG8_STAGE(PG8_SB(1, 1), cB + hstep + kstep, voffB);
        PG8_WAIT_V(6); PG8_BAR;
    }
    for (;;) {
        const bool has_next = S.next(ui + 1, nxt);
        const char* nA = has_next ? (const char*)g.A + (size_t)nxt.pm * tstep : cA; const char* nB = has_next ? (const char*)g.Bt + (size_t)nxt.pn * tstep : cB;
        for (int t = 0; t < nt; t += 2) {
            const bool last = (t == nt - 2);
            const char* a1 = cA + (size_t)(t + 1) * kstep;
            const char* a2 = last ? nA : cA + (size_t)(t + 2) * kstep; const char* b2 = last ? nB : cB + (size_t)(t + 2) * kstep;
            const char* a3 = a2 + kstep; const char* b3 = b2 + kstep;
            if (last && has_next) S.a_ready(nxt);
            if constexpr (SP2) {
            PG8_LDB(B0, 0, 0); PG8_LDB(B1, 0, 1); PG8_SCHED; PG8_LDA(At, 0, 0); PG8_STAGE(PG8_SA(1, 1), a1 + hstep, voffA);
            PG8_WAIT_V(8); PG8_WAIT_L(0); PG8_BAR; PG8_MMA(0, 0, At, B0); PG8_MMA(0, 1, At, B1); PG8_BAR; PG8_SCHED;
            PG8_LDA(At, 0, 1); PG8_STAGE(PG8_SB(0, 0), b2, voffB); PG8_STAGE(PG8_SB(0, 1), b2 + hstep, voffB); PG8_STAGE(PG8_SA(0, 0), a2, voffA);
            PG8_WAIT_V(8); PG8_WAIT_L(0); PG8_BAR; PG8_MMA(1, 0, At, B0); PG8_MMA(1, 1, At, B1); PG8_BAR; PG8_SCHED;
            PG8_LDB(B0, 1, 0); PG8_LDB(B1, 1, 1); PG8_SCHED; PG8_LDA(At, 1, 0); PG8_STAGE(PG8_SA(0, 1), a2 + hstep, voffA);
            PG8_WAIT_V(8); PG8_WAIT_L(0); PG8_BAR; PG8_MMA(0, 0, At, B0); PG8_MMA(0, 1, At, B1); PG8_BAR; PG8_SCHED;
            PG8_LDA(At, 1, 1); PG8_STAGE(PG8_SB(1, 0), b3, voffB); PG8_STAGE(PG8_SB(1, 1), b3 + hstep, voffB); PG8_STAGE(PG8_SA(1, 0), a3, voffA);
            PG8_WAIT_V(8); PG8_WAIT_L(0); PG8_BAR; PG8_MMA(1, 0, At, B0); PG8_MMA(1, 1, At, B1); PG8_BAR; PG8_SCHED;
            } else {
            PG8_LDB(B0, 0, 0); PG8_SCHED; PG8_LDA(At, 0, 0); PG8_STAGE(PG8_SA(1, 1), a1 + hstep, voffA);
            PG8_WAIT_L(8); PG8_BAR; PG8_WAIT_L(0); PG8_MMA(0, 0, At, B0); PG8_BAR; PG8_SCHED;
            PG8_LDB(B1, 0, 1); PG8_STAGE(PG8_SB(0, 0), b2, voffB);
            PG8_BAR; PG8_WAIT_L(0); PG8_MMA(0, 1, At, B1); PG8_BAR;
            PG8_LDA(At, 0, 1); PG8_STAGE(PG8_SA(0, 0), a2, voffA);
            PG8_BAR; PG8_WAIT_L(0); PG8_MMA(1, 0, At, B0); PG8_BAR; PG8_SCHED;
            PG8_STAGE(PG8_SB(0, 1), b2 + hstep, voffB);
            PG8_WAIT_V(6); PG8_BAR; PG8_MMA(1, 1, At, B1); PG8_BAR;
            PG8_LDB(B0, 1, 0); PG8_SCHED; PG8_LDA(At, 1, 0); PG8_STAGE(PG8_SA(0, 1), a2 + hstep, voffA);
            PG8_WAIT_L(8); PG8_BAR; PG8_WAIT_L(0); PG8_MMA(0, 0, At, B0); PG8_BAR; PG8_SCHED;
            PG8_LDB(B1, 1, 1); PG8_STAGE(PG8_SB(1, 0), b3, voffB);
            PG8_BAR; PG8_WAIT_L(0); PG8_MMA(0, 1, At, B1); PG8_BAR;
            PG8_LDA(At, 1, 1); PG8_STAGE(PG8_SA(1, 0), a3, voffA);
            PG8_BAR; PG8_WAIT_L(0); PG8_MMA(1, 0, At, B0); PG8_BAR; PG8_SCHED;
            PG8_STAGE(PG8_SB(1, 1), b3 + hstep, voffB);
            PG8_WAIT_V(6); PG8_BAR; PG8_MMA(1, 1, At, B1); PG8_BAR;
            }
        }
        if constexpr (ALIGN_EPI) { if (wr == 0) PG8_BAR; }
        if constexpr (!Epi::AFTER_DRAIN) { E(acc, cur, wr, wc, fr, fq); S.done(cur); }
        if (!has_next) break;
#pragma unroll
        for (int a = 0; a < 2; ++a)
#pragma unroll
            for (int b = 0; b < 2; ++b)
#pragma unroll
                for (int m = 0; m < 4; ++m)
#pragma unroll
                    for (int n = 0; n < 2; ++n) acc[a][b][m][n] = (f32x4){0.f, 0.f, 0.f, 0.f};
        cur = nxt; cA = nA; cB = nB; ++ui;
        if constexpr (ALIGN_EPI) { if (wr == 1) PG8_BAR; }
    }
    PG8_WAIT_V(0);
    if constexpr (!ALIGN_EPI) { if (wr == 0) PG8_BAR; }
    PG8_BAR;
    if constexpr (Epi::AFTER_DRAIN) { E.fused(acc, cur, wr, wc, fr, fq, lds, wid, lane); S.done(cur); }
#undef PG8_SA
#undef PG8_SB
#undef PG8_STAGE
#undef PG8_LDA
#undef PG8_LDB
#undef PG8_MMA
#undef PG8_WAIT_V
#undef PG8_WAIT_L
#undef PG8_BAR
#undef PG8_SCHED
}
}
#define XB_TMO      128
#define XB_XCNT(j)  (256  + 64 * (j))
#define XB_XSUB(j)  (1280 + 64 * (j))
#define XB_XGEN(j)  (2304 + 64 * (j))
#define XB_TOP      3328
#define XB_TOPGEN   3392
#define XCD_BAR_WORDS 3456
#define XB_SPIN_CAP (1u << 18)

__device__ __forceinline__ unsigned xb_ld(unsigned* p)              { return __hip_atomic_load(p, __ATOMIC_RELAXED, __HIP_MEMORY_SCOPE_AGENT); }
__device__ __forceinline__ unsigned xb_add(unsigned* p, unsigned v) { return __hip_atomic_fetch_add(p, v, __ATOMIC_RELAXED, __HIP_MEMORY_SCOPE_AGENT); }
__device__ __forceinline__ unsigned xb_xcc_id() { return (unsigned)__builtin_amdgcn_s_getreg((3 << 11) | 20) & 0xFu; }
#define XB_SPIN(cond, bar) do { unsigned _sp = 0; while (cond) { __builtin_amdgcn_s_sleep(1); \
    if ((++_sp & 255u) == 0u) { if (xb_ld(&(bar)[XB_TMO])) break; if (_sp > XB_SPIN_CAP) { atomicAdd(&(bar)[XB_TMO], 1u); break; } } } } while (0)

struct XcdBarrier {
    unsigned* bar; unsigned x;
    volatile LAS unsigned* st;
};

__device__ __forceinline__ XcdBarrier xcd_barrier_post(unsigned* bar, volatile LAS unsigned* st) {
    XcdBarrier b; b.bar = bar; b.x = xb_xcc_id(); b.st = st;
    if (threadIdx.x == 0) (void)xb_add(&bar[XB_XCNT(b.x)], 1u);
    return b;
}
__device__ __forceinline__ void xcd_barrier_complete(unsigned* bar, unsigned x, unsigned& nloc, unsigned& nx) {
    const unsigned G = gridDim.x * gridDim.y * gridDim.z;
    unsigned sum, cnt, mine, sp = 0u;
    for (;;) {
        sum = 0u; cnt = 0u; mine = 0u;
#pragma unroll
        for (unsigned j = 0; j < 16; ++j) { const unsigned c = xb_ld(&bar[XB_XCNT(j)]); sum += c; cnt += (c > 0u) ? 1u : 0u; mine = (j == x) ? c : mine; }
        if (sum == G) break;
        __builtin_amdgcn_s_sleep(1);
        if ((++sp & 255u) == 0u) { if (xb_ld(&bar[XB_TMO])) break; if (sp > XB_SPIN_CAP) { atomicAdd(&bar[XB_TMO], 1u); break; } }
    }
    nloc = mine > 0u ? mine : 1u; nx = cnt > 0u ? cnt : 1u;
}

__device__ __forceinline__ void xcd_barrier(const XcdBarrier& b) {
    asm volatile("s_waitcnt vmcnt(0)" ::: "memory");
    __syncthreads();
    if (threadIdx.x == 0) {
        unsigned* bar = b.bar;
        __builtin_amdgcn_s_waitcnt(0);
        unsigned nloc = b.st[0], nx = b.st[1];
        if (nloc == 0u) { xcd_barrier_complete(bar, b.x, nloc, nx); b.st[0] = nloc; b.st[1] = nx; }
        const unsigned old = xb_add(&bar[XB_XSUB(b.x)], 1u);
        const unsigned gen = old / nloc;
        if (old + 1u == (gen + 1u) * nloc) {
            __builtin_amdgcn_fence(__ATOMIC_RELEASE, "agent");
            asm volatile("s_waitcnt vmcnt(0)" ::: "memory");
            const unsigned og = xb_add(&bar[XB_TOP], 1u);
            const unsigned tg = og / nx;
            if (og + 1u == (tg + 1u) * nx) xb_add(&bar[XB_TOPGEN], 1u);
            else XB_SPIN(xb_ld(&bar[XB_TOPGEN]) == tg, bar);
            __builtin_amdgcn_fence(__ATOMIC_ACQUIRE, "agent");
            xb_add(&bar[XB_XGEN(b.x)], 1u);
            asm volatile("s_waitcnt vmcnt(0)" ::: "memory");
        } else {
            XB_SPIN(xb_ld(&bar[XB_XGEN(b.x)]) == gen, bar);
            __builtin_amdgcn_fence(__ATOMIC_ACQUIRE, "agent");
            asm volatile("s_waitcnt vmcnt(0)" ::: "memory");
        }
    }
    __syncthreads();
}
namespace attn {
constexpr int V_OFF = 0, K_OFF = 32768, EX_OFF = 65536;
#define ATT_KSWZ(row, colB) ((row) * 128 + ((colB) ^ ((((row) >> 1) & 7) << 4)))
#define ATT_SBAR() __builtin_amdgcn_sched_barrier(0)
__device__ __forceinline__ int crow(int r, int hi) { return (r & 3) + 8 * (r >> 2) + 4 * hi; }
__device__ __forceinline__ int v_st(int k, int c) { const int kk = (k & ~0xC) | ((k & 4) << 1) | ((k & 8) >> 1); return ((kk >> 3) * 4 + (c >> 5)) * 512 + ((kk & 7) * 32 + (c & 31)) * 2; }
__device__ __forceinline__ int v_rd_base(int lane) { return ((lane & 3) << 3) | (((lane >> 2) & 3) << 6) | (((lane >> 4) & 1) << 5) | (((lane >> 5) & 1) << 8); }
constexpr int v_rd_off(int d0, int ks, int half) { return d0 * 512 + ks * 4096 + half * 2048; }
template <int OFF> __device__ __forceinline__ s16x4 tr_read(int vb) {
    s16x4 r; asm volatile("ds_read_b64_tr_b16 %0, %1 offset:%2" : "=&v"(r) : "v"(vb), "i"(OFF) : "memory"); return r;
}
template <int D0> __device__ __forceinline__ void pv_one(f32x16& od, int vb, bf16x8 pa0, bf16x8 pa1, bf16x8 pa2, bf16x8 pa3) {
    const s16x4 l0 = tr_read<v_rd_off(D0, 0, 0)>(vb), h0 = tr_read<v_rd_off(D0, 0, 1)>(vb), l1 = tr_read<v_rd_off(D0, 1, 0)>(vb), h1 = tr_read<v_rd_off(D0, 1, 1)>(vb);
    const s16x4 l2 = tr_read<v_rd_off(D0, 2, 0)>(vb), h2 = tr_read<v_rd_off(D0, 2, 1)>(vb), l3 = tr_read<v_rd_off(D0, 3, 0)>(vb), h3 = tr_read<v_rd_off(D0, 3, 1)>(vb);
    asm volatile("s_waitcnt lgkmcnt(0)" ::: "memory"); ATT_SBAR();
#define ATT_PK(L, H) (bf16x8){L[0], L[1], L[2], L[3], H[0], H[1], H[2], H[3]}
    od = __builtin_amdgcn_mfma_f32_32x32x16_bf16(pa0, ATT_PK(l0, h0), od, 0, 0, 0);
    od = __builtin_amdgcn_mfma_f32_32x32x16_bf16(pa1, ATT_PK(l1, h1), od, 0, 0, 0);
    od = __builtin_amdgcn_mfma_f32_32x32x16_bf16(pa2, ATT_PK(l2, h2), od, 0, 0, 0);
    od = __builtin_amdgcn_mfma_f32_32x32x16_bf16(pa3, ATT_PK(l3, h3), od, 0, 0, 0);
#undef ATT_PK
}
__device__ __forceinline__ void pv_all(f32x16* o, int vb, bf16x8 pa0, bf16x8 pa1, bf16x8 pa2, bf16x8 pa3) {
    pv_one<0>(o[0], vb, pa0, pa1, pa2, pa3); pv_one<1>(o[1], vb, pa0, pa1, pa2, pa3); pv_one<2>(o[2], vb, pa0, pa1, pa2, pa3); pv_one<3>(o[3], vb, pa0, pa1, pa2, pa3);
}
__device__ __forceinline__ void qkt(f32x16& p0, f32x16& p1, const LAS unsigned char* Kt, const bf16x8* qr, float negref, int r32, int hi) {
#pragma unroll
    for (int r = 0; r < 16; ++r) { p0[r] = negref; p1[r] = negref; }
#pragma unroll
    for (int d0 = 0; d0 < 4; ++d0) { const int cb = (d0 * 16 + hi * 8) * 2;
        const bf16x8 b0 = *(const LAS bf16x8*)(Kt + ATT_KSWZ(r32, cb));
        const bf16x8 b1 = *(const LAS bf16x8*)(Kt + ATT_KSWZ(32 + r32, cb));
        p0 = __builtin_amdgcn_mfma_f32_32x32x16_bf16(b0, qr[d0], p0, 0, 0, 0);
        p1 = __builtin_amdgcn_mfma_f32_32x32x16_bf16(b1, qr[d0], p1, 0, 0, 0); }
}
__device__ __forceinline__ void exp_half(f32x16& p) {
#pragma unroll
    for (int r = 0; r < 16; ++r) p[r] = __builtin_amdgcn_exp2f(p[r]);
}
__device__ __forceinline__ void finish_sm(f32x16& p0, f32x16& p1, float& l_reg, bf16x8& pa0, bf16x8& pa1, bf16x8& pa2, bf16x8& pa3) {
    exp_half(p1);
    float ps = 0.f;
#pragma unroll
    for (int r = 0; r < 16; ++r) ps += p0[r];
#pragma unroll
    for (int r = 0; r < 16; ++r) ps += p1[r];
    l_reg += ps;
#define ATT_PK4(P, BASE, OUT) do { unsigned a0 = pk2(P[BASE + 0], P[BASE + 1]), a1 = pk2(P[BASE + 2], P[BASE + 3]);   \
    unsigned b0 = pk2(P[BASE + 4], P[BASE + 5]), b1 = pk2(P[BASE + 6], P[BASE + 7]);                              \
    auto r0 = __builtin_amdgcn_permlane32_swap(a0, b0, false, false); auto r1 = __builtin_amdgcn_permlane32_swap(a1, b1, false, false); \
    u32x4 w = {r0[0], r1[0], r0[1], r1[1]}; OUT = __builtin_bit_cast(bf16x8, w); } while (0)
    ATT_PK4(p0, 0, pa0); ATT_PK4(p0, 8, pa1); ATT_PK4(p1, 0, pa2); ATT_PK4(p1, 8, pa3);
#undef ATT_PK4
}

__device__ __forceinline__ void attn_unit(LAS unsigned char* lds, const bf16_t* __restrict__ Qh, const bf16_t* __restrict__ Kh, const bf16_t* __restrict__ Vh,
                                          int Sq, int Sk, int q0, bf16_t* __restrict__ outp, float lam, float negref, const float* __restrict__ subg) {
    const int tid = threadIdx.x, wid = __builtin_amdgcn_readfirstlane(tid >> 6), lane = tid & 63, r32 = lane & 31, hi = lane >> 5;
    const int comp = wid >> 2, qs = wid & 3;
    LAS unsigned char* V_lds = lds + V_OFF; LAS unsigned char* K_lds = lds + K_OFF;
    LAS float* wsf = (LAS float*)(lds + ATT_WSC_OFF) + wid * 64;
    bf16x8 qr[4];
    { const bf16_t* Qw = Qh + ((size_t)comp * Sq + q0 + qs * 32 + r32) * 64 + hi * 8;
#pragma unroll
      for (int d0 = 0; d0 < 4; ++d0) qr[d0] = *(const bf16x8*)(Qw + d0 * 16); }
    const int krow = tid >> 3, kcb = (tid & 7) * 16, kst = ATT_KSWZ(krow, kcb);
    const int sr = tid >> 4, sc = (tid & 15) * 8, vst0 = v_st(sr, sc), vst1 = v_st(32 + sr, sc);
    const bf16_t* Kg0 = Kh + tid * 8; const bf16_t* Kg1 = Kh + (size_t)Sk * 64 + tid * 8;
    const bf16_t* Vg0 = Vh + (size_t)sr * 128 + sc; const bf16_t* Vg1 = Vh + (size_t)(32 + sr) * 128 + sc;
    const int vb0 = (int)(unsigned)(uintptr_t)V_lds + v_rd_base(lane);
    const LAS unsigned char* Kc = K_lds + comp * 8192;
    bf16x8 sE_k0, sE_k1, sE_v0, sE_v1;
#define ATT_SLOAD(S, j) do { S##_k0 = *(const bf16x8*)(Kg0 + (size_t)(j) * 4096); S##_k1 = *(const bf16x8*)(Kg1 + (size_t)(j) * 4096); \
    S##_v0 = *(const bf16x8*)(Vg0 + (size_t)(j) * 8192); S##_v1 = *(const bf16x8*)(Vg1 + (size_t)(j) * 8192); } while (0)
#define ATT_SWRITE(b, S) do { *(LAS bf16x8*)(V_lds + (b) * 16384 + vst0) = S##_v0; *(LAS bf16x8*)(V_lds + (b) * 16384 + vst1) = S##_v1; \
    *(LAS bf16x8*)(K_lds + (b) * 16384 + kst) = S##_k0; *(LAS bf16x8*)(K_lds + (b) * 16384 + 8192 + kst) = S##_k1; } while (0)
#define ATT_SWAIT() asm volatile("s_waitcnt vmcnt(0)" ::: "memory")
    float l_reg = 0.f; f32x16 o[4];
#pragma unroll
    for (int d = 0; d < 4; ++d)
#pragma unroll
        for (int r = 0; r < 16; ++r) o[d][r] = 0.f;
    f32x16 pA0, pA1, pB0, pB1; bf16x8 pa0, pa1, pa2, pa3; const int NT = Sk / 64;
    ATT_SLOAD(sE, 0); asm volatile("s_waitcnt vmcnt(0)" ::: "memory"); ATT_SWRITE(0, sE); __syncthreads();
    qkt(pA0, pA1, Kc, qr, negref, r32, hi); exp_half(pA0);
    ATT_SLOAD(sE, 1);
    ATT_SWAIT(); ATT_SWRITE(1, sE); __syncthreads();
    for (int j = 1; j + 1 < NT; j += 2) {
        ATT_SBAR(); qkt(pB0, pB1, Kc + 16384, qr, negref, r32, hi);
        finish_sm(pA0, pA1, l_reg, pa0, pa1, pa2, pa3); ATT_SBAR();
        ATT_SLOAD(sE, j + 1); ATT_SBAR();
        pv_all(o, vb0, pa0, pa1, pa2, pa3); exp_half(pB0);
        __syncthreads(); ATT_SWAIT(); ATT_SWRITE(0, sE);
        __syncthreads();
        ATT_SBAR(); qkt(pA0, pA1, Kc, qr, negref, r32, hi);
        finish_sm(pB0, pB1, l_reg, pa0, pa1, pa2, pa3); ATT_SBAR();
        ATT_SLOAD(sE, j + 2); ATT_SBAR();
        pv_all(o, vb0 + 16384, pa0, pa1, pa2, pa3); exp_half(pA0);
        __syncthreads(); ATT_SWAIT(); ATT_SWRITE(1, sE);
        __syncthreads();
    }
    ATT_SBAR(); qkt(pB0, pB1, Kc + 16384, qr, negref, r32, hi);
    finish_sm(pA0, pA1, l_reg, pa0, pa1, pa2, pa3); ATT_SBAR();
    pv_all(o, vb0, pa0, pa1, pa2, pa3); exp_half(pB0);
    finish_sm(pB0, pB1, l_reg, pa0, pa1, pa2, pa3); ATT_SBAR();
    pv_all(o, vb0 + 16384, pa0, pa1, pa2, pa3);
#undef ATT_SLOAD
#undef ATT_SWRITE
#undef ATT_SWAIT
    { auto rr = __builtin_amdgcn_permlane32_swap(__float_as_uint(l_reg), __float_as_uint(l_reg), false, false); l_reg = __uint_as_float(rr[0]) + __uint_as_float(rr[1]); }
    int lz = lane; asm volatile("" : "+v"(lz));
    const int r32e = lz & 31, hie = lz >> 5;
    if (hie == 0) wsf[r32e] = l_reg;
    LDS_WAIT();
    float rli[16];
#pragma unroll
    for (int r = 0; r < 16; ++r) rli[r] = 1.0f / wsf[(r & 3) + 8 * (r >> 2) + 4 * hie];
    LAS float* ex = (LAS float*)(lds + EX_OFF) + qs * 4096;
    LAS float* exl = ex + lz;
    if (comp == 1) {
#pragma unroll
        for (int d0 = 0; d0 < 4; ++d0)
#pragma unroll
            for (int r = 0; r < 16; ++r) exl[(d0 * 16 + r) * 64] = o[d0][r] * rli[r];
    }
    __syncthreads();
    if (comp == 0) {
#pragma unroll
        for (int d0 = 0; d0 < 4; ++d0)
#pragma unroll
            for (int r = 0; r < 16; ++r) o[d0][r] = o[d0][r] * rli[r] - lam * exl[(d0 * 16 + r) * 64];
        LDS_WAIT(); asm volatile("" ::: "memory");
        LAS float* wb[4];
#pragma unroll
        for (int q = 0; q < 4; ++q) { const int rq = q + 4 * hie; wb[q] = ex + rq * 128 + (r32e ^ (rq << 2)); }
#pragma unroll
        for (int d0 = 0; d0 < 4; ++d0)
#pragma unroll
            for (int r = 0; r < 16; ++r) wb[r & 3][(r >> 2) * 1024 + d0 * 32] = o[d0][r];
        LDS_WAIT(); asm volatile("" ::: "memory");
        const int row2 = lz >> 1, half = lz & 1, x3 = (row2 & 7) << 2;
        const LAS float* rb = ex + row2 * 128 + 64 * half;
        f32x4 v[16]; float ss = 0.f;
#pragma unroll
        for (int i = 0; i < 16; ++i) { v[i] = *(const LAS f32x4*)(rb + ((4 * i) ^ x3)); ss += (v[i][0] * v[i][0] + v[i][1] * v[i][1]) + (v[i][2] * v[i][2] + v[i][3] * v[i][3]); }
        ss += __shfl_xor(ss, 1);
        const float rinv = rsqrtf(ss * (1.0f / 128.0f) + EPS) * ONE_M_LAMINIT;
        bf16_t* orow = outp + (size_t)(q0 + qs * 32 + row2) * KOUT + 64 * half;
        const float* sg = subg + 64 * half;
#pragma unroll
        for (int i = 0; i < 8; ++i) { const f32x4 g0 = *(const f32x4*)(sg + 8 * i), g1 = *(const f32x4*)(sg + 8 * i + 4); const f32x4 a = v[2 * i] * rinv * g0, b = v[2 * i + 1] * rinv * g1;
            u32x4 w; w.x = pk2(a[0], a[1]); w.y = pk2(a[2], a[3]); w.z = pk2(b[0], b[1]); w.w = pk2(b[2], b[3]); *(u32x4*)(orow + 8 * i) = w; }
    }
}
#undef ATT_KSWZ
#undef ATT_SBAR
}
struct Params {
    const float *x_p, *x_s, *cache_k, *cache_v, *c, *c_ctx, *n1, *n2, *w_ada, *b_ada, *w_in, *qg, *kg, *lq1, *lk1, *lq2, *lk2, *subg, *w_out, *w_gate, *w_up, *conv_w, *conv_b, *w_down;
    float* out; unsigned char* ws; int ph_lo, ph_hi, li, pad;
};
__device__ __forceinline__ int invperm32(int c) { return 16 * ((c >> 2) & 1) + 4 * (c >> 3) + (c & 3); }
__device__ __forceinline__ int rowperm(int n) { return (n & ~31) | invperm32(n & 31); }
__device__ __forceinline__ const float* xrow_ptr(const Params& P, int m) { return m < NTOK_P ? P.x_p + (size_t)m * DM : P.x_s + (size_t)(m - NTOK_P) * DM; }
__device__ __forceinline__ int modrow_of_tile(int pm) { return pm < 16 ? 0 : 1 + ((pm - 16) >> 2); }

template <int NC> __device__ __forceinline__ void gemv9_slab(const LAS float* vec, LAS float* red, const float* __restrict__ W, int ldw, int c0, const float* __restrict__ bias, float* __restrict__ out, int ldo, int oc0, int tid) {
    constexpr int NCG = NC / 4, KPAR = 512 / NCG, KP = KPAR + 1;
    const int cg = tid % NCG, ks = tid / NCG;
    float a[9][4];
#pragma unroll
    for (int j = 0; j < 9; ++j)
#pragma unroll
        for (int e = 0; e < 4; ++e) a[j][e] = 0.f;
    if (ks < KPAR) {
        constexpr int NI = (1024 + KPAR - 1) / KPAR;
        f32x4 w[NI];
#pragma unroll
        for (int i = 0; i < NI; ++i) { const int k = ks + i * KPAR; w[i] = (k < 1024) ? *(const f32x4*)(W + (size_t)k * ldw + c0 + 4 * cg) : (f32x4){0.f, 0.f, 0.f, 0.f}; }
#pragma unroll
        for (int i = 0; i < NI; ++i) { const int k = ks + i * KPAR; const int kc = k < 1024 ? k : 1023;
#pragma unroll
            for (int j = 0; j < 9; ++j) { const float v = vec[j * 1024 + kc]; a[j][0] += v * w[i][0]; a[j][1] += v * w[i][1]; a[j][2] += v * w[i][2]; a[j][3] += v * w[i][3]; }
        }
#pragma unroll
        for (int j = 0; j < 9; ++j)
#pragma unroll
            for (int e = 0; e < 4; ++e) red[(j * NC + cg * 4 + e) * KP + ks] = a[j][e];
    }
    __syncthreads();
    if (tid < 9 * NC) { float s = 0.f; for (int q = 0; q < KPAR; ++q) s += red[tid * KP + q]; const int j = tid / NC, c = tid % NC; out[(size_t)j * ldo + oc0 + c] = s + (bias ? bias[oc0 + c] : 0.f); }
    __syncthreads();
}
template <class DestRow>
__device__ __forceinline__ void transpose_item(const float* __restrict__ W, int ldw, int k0, int n0, bf16_t* __restrict__ WT, int ldt, int kd0, DestRow dest, LAS float* scr, int lane) {
    float tv[32];
#pragma unroll
    for (int i = 0; i < 32; ++i) tv[i] = W[(size_t)(k0 + 2 * i + (lane >> 5)) * ldw + n0 + (lane & 31)];
#pragma unroll
    for (int i = 0; i < 32; ++i) scr[(2 * i + (lane >> 5)) * 33 + (lane & 31)] = tv[i];
    LDS_WAIT(); asm volatile("" ::: "memory");
    const int c = lane & 7;
#pragma unroll
    for (int j = 0; j < 4; ++j) { const int n = (lane >> 3) + 8 * j; const LAS float* s = scr + (8 * c) * 33 + n;
        u32x4 o; o.x = pk2(s[0 * 33], s[1 * 33]); o.y = pk2(s[2 * 33], s[3 * 33]); o.z = pk2(s[4 * 33], s[5 * 33]); o.w = pk2(s[6 * 33], s[7 * 33]);
        *(u32x4*)(WT + (size_t)dest(n0 + n) * ldt + kd0 + 8 * c) = o; }
    LDS_WAIT(); asm volatile("" ::: "memory");
}
struct DestIn { __device__ __forceinline__ int operator()(int n) const { const int tile = n >> 8, tc = n & 255; int p;
    if (tile == 0) p = tc; else if (tile <= 6) p = 128 * ((tc >> 5) & 1) + 32 * (tc >> 6) + (tc & 31); else p = rowperm(tc); return tile * 256 + p; } };
struct DestPerm { __device__ __forceinline__ int operator()(int n) const { return rowperm(n); } };
struct DestGU { int up; __device__ __forceinline__ int operator()(int f) const { return (f >> 7) * 256 + up * 128 + rowperm(f & 127); } };
__device__ __forceinline__ void fout_item(const float* __restrict__ w_out, bf16_t* __restrict__ WT, int h, int nb, LAS float* scr, int lane) {
#pragma unroll
    for (int i = 0; i < 16; ++i) { const int d = 4 * i + (lane >> 4), j = lane & 15; scr[d * 17 + j] = w_out[(size_t)(64 * h + d) * DM + 16 * nb + j]; }
    LAS float* ctab = scr + 1088; LAS float* stab = scr + 1152;
    ctab[lane] = __builtin_amdgcn_cosf((float)lane * (1.0f / 64.0f)); stab[lane] = __builtin_amdgcn_sinf((float)lane * (1.0f / 64.0f));
    LDS_WAIT(); asm volatile("" ::: "memory");
    float ac[16], as_[16];
#pragma unroll
    for (int j = 0; j < 16; ++j) { ac[j] = 0.f; as_[j] = 0.f; }
#pragma unroll 2
    for (int d = 0; d < 64; ++d) { const int idx = (d * lane) & 63; const float cv = ctab[idx], sv = stab[idx];
#pragma unroll
        for (int j = 0; j < 16; ++j) { const float w = scr[d * 17 + j]; ac[j] += cv * w; as_[j] += sv * w; } }
#pragma unroll
    for (int j = 0; j < 16; ++j) { const int row = rowperm(16 * nb + j);
        WT[(size_t)row * KOUT + 64 * h + lane] = f2bf(ac[j] * 0.125f); WT[(size_t)row * KOUT + 256 + 64 * h + lane] = f2bf(-as_[j] * 0.125f); }
    LDS_WAIT(); asm volatile("" ::: "memory");
}

constexpr int I_TIN = 16 * 80, I_TOUT = 12 * 32, I_TG = 16 * 88, I_TU = 16 * 88, I_TDN = 44 * 32, I_FOUT = 4 * 64, I_CK = 768, I_CV = 768, I_DFTS = 4096, I_DFTP = 256, I_ROPE = 1;
constexpr int P0_ITEMS = I_TIN + I_TOUT + I_TG + I_TU + I_TDN + I_FOUT + I_CK + I_CV + I_DFTS + I_DFTP + I_ROPE;
__device__ __forceinline__ void p0_prep(const Params& P, LAS unsigned char* lds, int tid, int lane, int wave, int vcu, int G) {
    unsigned char* ws = P.ws;
    LAS float* vec = (LAS float*)lds; LAS float* red = (LAS float*)(lds + 36864);
    for (int i = tid; i < 9 * 1024; i += 512) { const int j = i >> 10, k = i & 1023; const float x = (j == 0) ? P.c_ctx[k] : P.c[(j - 1) * 1024 + k]; vec[i] = x / (1.0f + expf(-x)); }
    __syncthreads();
    for (int s = blockIdx.x; s < NADA / 24; s += G) gemv9_slab<24>(vec, red, P.w_ada, NADA, 24 * s, P.b_ada, (float*)(ws + WS_ADA), NADA, 24 * s, tid);
    __syncthreads();
    LAS float* scr = (LAS float*)(lds + wave * 9216);
    bf16_t* Wt_in = (bf16_t*)(ws + WS_WIN); bf16_t* Wt_out = (bf16_t*)(ws + WS_WOUT); bf16_t* Wt_gu = (bf16_t*)(ws + WS_WGU); bf16_t* Wt_dn = (bf16_t*)(ws + WS_WDN);
    const int gw = vcu * NWAVES + wave, NGW = G * NWAVES;
    for (int it = gw; it < P0_ITEMS; it += NGW) {
        int r = it;
        if (r < I_TIN) { transpose_item(P.w_in, DIN, 64 * (r / 80), 32 * (r % 80), Wt_in, DM, 64 * (r / 80), DestIn{}, scr, lane); continue; } r -= I_TIN;
        if (r < I_TOUT) { const int kb = r >> 5, nb = r & 31; transpose_item(P.w_out, DM, 256 + 64 * kb, 32 * nb, Wt_out, KOUT, 512 + 64 * kb, DestPerm{}, scr, lane); continue; } r -= I_TOUT;
        if (r < I_TG) { transpose_item(P.w_gate, DFF, 64 * (r / 88), 32 * (r % 88), Wt_gu, DM, 64 * (r / 88), DestGU{0}, scr, lane); continue; } r -= I_TG;
        if (r < I_TU) { transpose_item(P.w_up, DFF, 64 * (r / 88), 32 * (r % 88), Wt_gu, DM, 64 * (r / 88), DestGU{1}, scr, lane); continue; } r -= I_TU;
        if (r < I_TDN) { const int kb = r >> 5, nb = r & 31; transpose_item(P.w_down, DM, 64 * kb, 32 * nb, Wt_dn, DFF, 64 * kb, DestPerm{}, scr, lane); continue; } r -= I_TDN;
        if (r < I_FOUT) { fout_item(P.w_out, Wt_out, r >> 6, r & 63, scr, lane); continue; } r -= I_FOUT;
        if (r < I_CK) {
            bf16_t* Ks = (bf16_t*)(ws + WS_K_S); float mx = 0.f;
            f32x4 xv[16];
#pragma unroll
            for (int j = 0; j < 16; ++j) xv[j] = *(const f32x4*)(P.cache_k + (size_t)(r * 1024 + j * 64 + lane) * 4);
#pragma unroll
            for (int j = 0; j < 16; ++j) { const int q4 = r * 1024 + j * 64 + lane, e = q4 * 4; const f32x4 x = xv[j];
                const int d = e & 63, cc = (e >> 6) & 1, p = (e >> 7) & 511, bh = e >> 16;
                u32x2 w; w.x = pk2(x[0], x[1]); w.y = pk2(x[2], x[3]); *(u32x2*)(Ks + ((size_t)(bh * 2 + cc) * SKS + 1024 + p) * 64 + d) = w;
                float ss = (x[0] * x[0] + x[1] * x[1]) + (x[2] * x[2] + x[3] * x[3]);
                ss += __shfl_xor(ss, 1); ss += __shfl_xor(ss, 2); ss += __shfl_xor(ss, 4); ss += __shfl_xor(ss, 8); mx = fmaxf(mx, ss); }
            mx = wave_max(mx);
            if (lane == 0) atomicMax((unsigned*)(ws + WS_CTL) + CW_KMAX, __float_as_uint(mx));
            continue; } r -= I_CK;
        if (r < I_CV) {
            bf16_t* Vs = (bf16_t*)(ws + WS_V_S);
            f32x4 xv[16];
#pragma unroll
            for (int j = 0; j < 16; ++j) xv[j] = *(const f32x4*)(P.cache_v + (size_t)(r * 1024 + j * 64 + lane) * 4);
#pragma unroll
            for (int j = 0; j < 16; ++j) { const int q4 = r * 1024 + j * 64 + lane, e = q4 * 4; const f32x4 x = xv[j];
                const int dv = e & 127, p = (e >> 7) & 511, bh = e >> 16;
                u32x2 w; w.x = pk2(x[0], x[1]); w.y = pk2(x[2], x[3]); *(u32x2*)(Vs + ((size_t)bh * SKS + 1024 + p) * 128 + dv) = w; }
            continue; } r -= I_CV;
        if (r < I_DFTS + I_DFTP) {
            const bool smp = r < I_DFTS; const int lg = smp ? 10 : 8, S = 1 << lg; const int item = smp ? r : r - I_DFTS; bf16_t* Dm = (bf16_t*)(ws + (smp ? WS_DFTS : WS_DFTP));
            const float sc = smp ? 0.03125f : 0.0625f, invS = 1.0f / (float)S; const int idx0 = item * 512 + lane * 8, f = idx0 >> lg, s0 = idx0 & (S - 1), kf = f & (S - 1); const bool isSin = f >= S;
            float v[8];
#pragma unroll
            for (int i = 0; i < 8; ++i) { const float fr = (float)((kf * (s0 + i)) & (S - 1)) * invS; v[i] = (isSin ? __builtin_amdgcn_sinf(fr) : __builtin_amdgcn_cosf(fr)) * sc; }
            u32x4 w; w.x = pk2(v[0], v[1]); w.y = pk2(v[2], v[3]); w.z = pk2(v[4], v[5]); w.w = pk2(v[6], v[7]); *(u32x4*)(Dm + idx0) = w;
            continue; } r -= I_DFTS + I_DFTP;
        {
            f32x2* T = (f32x2*)(ws + WS_ROPE);
#pragma unroll
            for (int j = 0; j < 16; ++j) { const int ent = j * 64 + lane, pos = ent >> 4, i = ent & 15; const float inv = powf(10000.0f, -(float)i * (1.0f / 16.0f)); const float ang = (float)pos * inv, rev = ang * 0.15915494309189535f;
                T[ent] = (f32x2){__builtin_amdgcn_cosf(rev), __builtin_amdgcn_sinf(rev)}; }
        }
    }
}

__device__ __forceinline__ void p1_norm(const Params& P, LAS unsigned char* lds, int tid, int lane, int wave, int vcu, int G) {
    unsigned char* ws = P.ws; const float* ada = (const float*)(ws + WS_ADA);
    LAS float* vec = (LAS float*)lds; LAS float* red = (LAS float*)(lds + 36864);
    for (int i = tid; i < 9 * 1024; i += 512) { const int j = i >> 10, k = i & 1023; vec[i] = ada[(size_t)j * NADA + 3072 + k]; }
    __syncthreads();
    for (int s = blockIdx.x; s < 352; s += G) { const int mat = s / 176, c0 = (s % 176) * 16;
        gemv9_slab<16>(vec, red, mat ? P.w_up : P.w_gate, DFF, c0, nullptr, (float*)(ws + WS_BIAS2), NGU, mat * DFF + c0, tid); }
    bf16_t* Hb = (bf16_t*)(ws + WS_H);
    const int gw = vcu * NWAVES + wave, NGW = G * NWAVES;
    f32x4 g1v[4];
#pragma unroll
    for (int j = 0; j < 4; ++j) g1v[j] = ((const f32x4*)P.n1)[lane + 64 * j];
    f32x4 xv[4], shv[4], scv[4];
#define P1_LOAD(m_) do { const int mr_ = (m_) < NTOK_P ? 0 : 1 + (((m_) - NTOK_P) >> 10); const f32x4* xr_ = (const f32x4*)xrow_ptr(P, (m_)) + lane; \
        const f32x4* sh_ = (const f32x4*)(ada + (size_t)mr_ * NADA) + lane; const f32x4* sc_ = (const f32x4*)(ada + (size_t)mr_ * NADA + 1024) + lane; \
        _Pragma("unroll") for (int j = 0; j < 4; ++j) { xv[j] = xr_[64 * j]; shv[j] = sh_[64 * j]; scv[j] = sc_[64 * j]; } } while (0)
    if (gw < NTOK) P1_LOAD(gw);
    for (int m = gw; m < NTOK; m += NGW) {
        f32x4 v[4], shc[4], scc[4];
#pragma unroll
        for (int j = 0; j < 4; ++j) { v[j] = xv[j]; shc[j] = shv[j]; scc[j] = scv[j]; }
        if (m + NGW < NTOK) P1_LOAD(m + NGW);
        float s = 0.f;
#pragma unroll
        for (int j = 0; j < 4; ++j) s += (v[j][0] * v[j][0] + v[j][1] * v[j][1]) + (v[j][2] * v[j][2] + v[j][3] * v[j][3]);
        const float rstd = rsqrtf(wave_sum(s) * (1.0f / DM) + EPS);
        u32x2* o8 = (u32x2*)(Hb + (size_t)m * DM) + lane;
#pragma unroll
        for (int j = 0; j < 4; ++j) { const f32x4 hv = v[j] * rstd * g1v[j] * (scc[j] + 1.0f) + shc[j]; u32x2 w; w.x = pk2(hv[0], hv[1]); w.y = pk2(hv[2], hv[3]); o8[64 * j] = w; }
    }
#undef P1_LOAD
}

using pg8::Unit;
struct EpiInProj {
    static constexpr bool PERM = false, AFTER_DRAIN = false;
    unsigned char* ws; float* newk; float* newv; const float* qg; const float* kg;
    __device__ __forceinline__ void operator()(const f32x4 (&acc)[2][2][4][2], const Unit& u, int wr, int wc, int fr_, int fq_) const {
        int fr = fr_, fq = fq_; asm volatile("" : "+v"(fr), "+v"(fq));
        const bool prompt = u.pm < 16; const int b = prompt ? u.pm : (u.pm - 16) >> 2; const int s0 = prompt ? 0 : ((u.pm - 16) & 3) * 256; const int S = prompt ? SP : SS, Sk = prompt ? SP : SKS;
        if (u.pn == 0) {
            bf16_t* base = (bf16_t*)(ws + (prompt ? WS_XFT_P : WS_XFT_S)) + (size_t)b * 256 * S;
#pragma unroll
            for (int ai = 0; ai < 2; ++ai)
#pragma unroll
                for (int m = 0; m < 4; ++m) { const int s = s0 + 128 * ai + 64 * wr + 16 * m + fr;
#pragma unroll
                    for (int bj = 0; bj < 2; ++bj)
#pragma unroll
                        for (int n = 0; n < 2; ++n)
#pragma unroll
                            for (int e = 0; e < 4; ++e) { const int ch = 128 * bj + 32 * wc + 16 * n + 4 * fq + e; base[(size_t)ch * S + s] = f2bf(acc[ai][bj][m][n][e]); } }
        } else if (u.pn <= 6) {
            const bool isq = u.pn <= 3; const int t = isq ? u.pn - 1 : u.pn - 4; const int head = 2 * t + (wc >> 1), comp = wc & 1;
            const float* gsrc = isq ? qg : kg; f32x4 g[2][2];
#pragma unroll
            for (int bj = 0; bj < 2; ++bj)
#pragma unroll
                for (int n = 0; n < 2; ++n) g[bj][n] = *(const f32x4*)(gsrc + 32 * bj + 16 * n + 4 * fq);
            bf16_t* dst = isq ? (bf16_t*)(ws + (prompt ? WS_Q_P : WS_Q_S)) + ((size_t)((b * NH + head) * 2 + comp) * S) * 64
                              : (bf16_t*)(ws + (prompt ? WS_K_P : WS_K_S)) + ((size_t)((b * NH + head) * 2 + comp) * Sk) * 64;
            const f32x2* rope = (const f32x2*)(ws + WS_ROPE);
#pragma unroll
            for (int ai = 0; ai < 2; ++ai) {
#pragma unroll
                for (int m = 0; m < 4; ++m) { const int s = s0 + 128 * ai + 64 * wr + 16 * m + fr;
                    f32x4 rt[2][2];
#pragma unroll
                    for (int bj = 0; bj < 2; ++bj) { const int pos = bj == 0 ? (s >> 6) : (s & 63); const f32x4* tp = (const f32x4*)(rope + pos * 16 + 4 * fq); rt[bj][0] = tp[0]; rt[bj][1] = tp[1]; }
                    f32x4 v[2][2]; float ss = 0.f;
#pragma unroll
                    for (int bj = 0; bj < 2; ++bj)
#pragma unroll
                        for (int n = 0; n < 2; ++n) { v[bj][n] = acc[ai][bj][m][n]; ss += (v[bj][n][0] * v[bj][n][0] + v[bj][n][1] * v[bj][n][1]) + (v[bj][n][2] * v[bj][n][2] + v[bj][n][3] * v[bj][n][3]); }
                    ss += __shfl_xor(ss, 16); ss += __shfl_xor(ss, 32);
                    const float rinv = rsqrtf(ss * (1.0f / 64.0f) + EPS);
#pragma unroll
                    for (int bj = 0; bj < 2; ++bj)
#pragma unroll
                        for (int n = 0; n < 2; ++n) v[bj][n] = v[bj][n] * rinv * g[bj][n];
                    if (!prompt) {
#pragma unroll
                        for (int bj = 0; bj < 2; ++bj) { const f32x4 t0 = rt[bj][0], t1 = rt[bj][1];
                            const float cs[4] = {t0[0], t0[2], t1[0], t1[2]}, sn[4] = {t0[1], t0[3], t1[1], t1[3]};
#pragma unroll
                            for (int e = 0; e < 4; ++e) { const float x1 = v[bj][0][e], x2 = v[bj][1][e]; v[bj][0][e] = x1 * cs[e] - x2 * sn[e]; v[bj][1][e] = x2 * cs[e] + x1 * sn[e]; } }
                    }
                    if (!isq && prompt) { float* nk = newk + ((size_t)((b * NH + head) * SP + s) * 2 + comp) * 64 + 4 * fq;
#pragma unroll
                        for (int bj = 0; bj < 2; ++bj)
#pragma unroll
                            for (int n = 0; n < 2; ++n) *(f32x4*)(nk + 32 * bj + 16 * n) = v[bj][n]; }
                    const float osc = isq ? C2 : 1.0f; bf16_t* drow = dst + (size_t)s * 64 + 4 * fq;
#pragma unroll
                    for (int bj = 0; bj < 2; ++bj)
#pragma unroll
                        for (int n = 0; n < 2; ++n) { const f32x4 x = v[bj][n] * osc; u32x2 w; w.x = pk2(x[0], x[1]); w.y = pk2(x[2], x[3]); *(u32x2*)(drow + 32 * bj + 16 * n) = w; }
                    asm volatile("" ::: "memory");
                }
            }
        } else {
            const int t = u.pn - 7;
#pragma unroll
            for (int bj = 0; bj < 2; ++bj) { const int head = 2 * t + bj;
                bf16_t* dst = (bf16_t*)(ws + (prompt ? WS_V_P : WS_V_S)) + ((size_t)(b * NH + head) * Sk) * 128 + 32 * wc + 8 * fq;
                float* nv = newv + ((size_t)(b * NH + head) * SP) * 128 + 32 * wc + 8 * fq;
#pragma unroll
                for (int ai = 0; ai < 2; ++ai)
#pragma unroll
                    for (int m = 0; m < 4; ++m) { const int s = s0 + 128 * ai + 64 * wr + 16 * m + fr; const f32x4 a = acc[ai][bj][m][0], c = acc[ai][bj][m][1];
                        u32x4 w; w.x = pk2(a[0], a[1]); w.y = pk2(a[2], a[3]); w.z = pk2(c[0], c[1]); w.w = pk2(c[2], c[3]); *(u32x4*)(dst + (size_t)s * 128) = w;
                        if (prompt) { *(f32x4*)(nv + (size_t)s * 128) = a; *(f32x4*)(nv + (size_t)s * 128 + 4) = c; } } }
        }
    }
};
struct EpiFourier {
    static constexpr bool PERM = false, AFTER_DRAIN = false;
    bf16_t* mix; int S, tok0;
    __device__ __forceinline__ void operator()(const f32x4 (&acc)[2][2][4][2], const Unit& u, int wr, int wc, int fr_, int fq_) const {
        int fr = fr_, fq = fq_; asm volatile("" : "+v"(fr), "+v"(fq));
        const int f0 = u.pm * 256, part = f0 >= S ? 1 : 0; const int k0 = f0 - part * S;
#pragma unroll
        for (int ai = 0; ai < 2; ++ai)
#pragma unroll
            for (int m = 0; m < 4; ++m) { bf16_t* rowp = mix + (size_t)(tok0 + u.pn * S + k0 + 128 * ai + 64 * wr + 16 * m + fr) * KOUT + part * 256 + 32 * wc + 4 * fq;
#pragma unroll
                for (int bj = 0; bj < 2; ++bj)
#pragma unroll
                    for (int n = 0; n < 2; ++n) { const f32x4 x = acc[ai][bj][m][n]; u32x2 w; w.x = pk2(x[0], x[1]); w.y = pk2(x[2], x[3]); *(u32x2*)(rowp + 128 * bj + 16 * n) = w; } }
    }
};
struct EpiOut {
    static constexpr bool PERM = false, AFTER_DRAIN = false;
    Params P;
    __device__ __forceinline__ void operator()(const f32x4 (&acc)[2][2][4][2], const Unit& u, int wr, int wc, int fr_, int fq_) const {
        int fr = fr_, fq = fq_; asm volatile("" : "+v"(fr), "+v"(fq));
        const float* ada = (const float*)(P.ws + WS_ADA) + (size_t)modrow_of_tile(u.pm) * NADA; bf16_t* x1s = (bf16_t*)(P.ws + WS_H); float* ssq = (float*)(P.ws + WS_SSQ);
        const int c0 = u.pn * 256 + 32 * wc + 8 * fq;
        f32x4 g1[2][2], md[2][2];
#pragma unroll
        for (int bj = 0; bj < 2; ++bj)
#pragma unroll
            for (int n = 0; n < 2; ++n) { const int c = c0 + 128 * bj + 4 * n; g1[bj][n] = *(const f32x4*)(ada + 2048 + c); md[bj][n] = *(const f32x4*)(P.n2 + c) * (*(const f32x4*)(ada + 4096 + c) + 1.0f); }
#pragma unroll
        for (int am = 0; am < 4; ++am) { const int ai = am >> 1;
            f32x4 xv[4][2][2];
#pragma unroll
            for (int m = 2 * (am & 1); m < 2 * (am & 1) + 2; ++m) { const int r = u.pm * 256 + 128 * ai + 64 * wr + 16 * m + fr; const float* xr = xrow_ptr(P, r) + c0;
#pragma unroll
                for (int bj = 0; bj < 2; ++bj) { xv[m][bj][0] = *(const f32x4*)(xr + 128 * bj); xv[m][bj][1] = *(const f32x4*)(xr + 128 * bj + 4); } }
#pragma unroll
            for (int m = 2 * (am & 1); m < 2 * (am & 1) + 2; ++m) { const int r = u.pm * 256 + 128 * ai + 64 * wr + 16 * m + fr; float* yr = P.out + (size_t)r * DM + c0; bf16_t* hr = x1s + (size_t)r * DM + c0;
                float ss = 0.f;
#pragma unroll
                for (int bj = 0; bj < 2; ++bj) {
                    const f32x4 ya = xv[m][bj][0] + g1[bj][0] * acc[ai][bj][m][0], yb = xv[m][bj][1] + g1[bj][1] * acc[ai][bj][m][1];
                    *(f32x4*)(yr + 128 * bj) = ya; *(f32x4*)(yr + 128 * bj + 4) = yb;
                    ss += (ya[0] * ya[0] + ya[1] * ya[1]) + (ya[2] * ya[2] + ya[3] * ya[3]) + (yb[0] * yb[0] + yb[1] * yb[1]) + (yb[2] * yb[2] + yb[3] * yb[3]);
                    const f32x4 ha = ya * md[bj][0], hb = yb * md[bj][1]; u32x4 w; w.x = pk2(ha[0], ha[1]); w.y = pk2(ha[2], ha[3]); w.z = pk2(hb[0], hb[1]); w.w = pk2(hb[2], hb[3]); *(u32x4*)(hr + 128 * bj) = w; }
                ss += __shfl_xor(ss, 16); ss += __shfl_xor(ss, 32);
                if (fq == 0) ssq[(size_t)r * 16 + u.pn * 4 + wc] = ss; }
        }
    }
};
struct EpiGU {
    static constexpr bool PERM = false, AFTER_DRAIN = false;
    unsigned char* ws;
    __device__ __forceinline__ void operator()(const f32x4 (&acc)[2][2][4][2], const Unit& u, int wr, int wc, int fr_, int fq_) const {
        int fr = fr_, fq = fq_; asm volatile("" : "+v"(fr), "+v"(fq));
        const float* b2 = (const float*)(ws + WS_BIAS2) + (size_t)modrow_of_tile(u.pm) * NGU; const float* ssq = (const float*)(ws + WS_SSQ);
        bf16_t* Gb = (bf16_t*)(ws + WS_G); bf16_t* Ub = (bf16_t*)(ws + WS_U);
        const int f0 = u.pn * 128 + 32 * wc + 8 * fq;
        const f32x4 bg0 = *(const f32x4*)(b2 + f0), bg1 = *(const f32x4*)(b2 + f0 + 4), bu0 = *(const f32x4*)(b2 + DFF + f0), bu1 = *(const f32x4*)(b2 + DFF + f0 + 4);
#pragma unroll
        for (int ai = 0; ai < 2; ++ai) {
            f32x4 sv[4][4];
#pragma unroll
            for (int m = 0; m < 4; ++m) { const int r = u.pm * 256 + 128 * ai + 64 * wr + 16 * m + fr; const f32x4* sp = (const f32x4*)(ssq + (size_t)r * 16);
#pragma unroll
                for (int q = 0; q < 4; ++q) sv[m][q] = sp[q]; }
#pragma unroll
            for (int m = 0; m < 4; ++m) { const int r = u.pm * 256 + 128 * ai + 64 * wr + 16 * m + fr;
                const f32x4 s0 = sv[m][0], s1 = sv[m][1], s2 = sv[m][2], s3 = sv[m][3];
                const float tot = ((s0[0] + s0[1]) + (s0[2] + s0[3])) + ((s1[0] + s1[1]) + (s1[2] + s1[3])) + ((s2[0] + s2[1]) + (s2[2] + s2[3])) + ((s3[0] + s3[1]) + (s3[2] + s3[3]));
                const float rstd = rsqrtf(tot * (1.0f / DM) + EPS);
                const f32x4 ga = acc[ai][0][m][0] * rstd + bg0, gb = acc[ai][0][m][1] * rstd + bg1, ua = acc[ai][1][m][0] * rstd + bu0, ub = acc[ai][1][m][1] * rstd + bu1;
                u32x4 w; w.x = pk2(ga[0], ga[1]); w.y = pk2(ga[2], ga[3]); w.z = pk2(gb[0], gb[1]); w.w = pk2(gb[2], gb[3]); *(u32x4*)(Gb + (size_t)r * DFF + f0) = w;
                u32x4 z; z.x = pk2(ua[0], ua[1]); z.y = pk2(ua[2], ua[3]); z.z = pk2(ub[0], ub[1]); z.w = pk2(ub[2], ub[3]); *(u32x4*)(Ub + (size_t)r * DFF + f0) = z; }
        }
    }
};
struct EpiDown {
    static constexpr bool PERM = false, AFTER_DRAIN = false;
    unsigned char* ws; float* out;
    __device__ __forceinline__ void operator()(const f32x4 (&acc)[2][2][4][2], const Unit& u, int wr, int wc, int fr_, int fq_) const {
        int fr = fr_, fq = fq_; asm volatile("" : "+v"(fr), "+v"(fq));
        const float* ada = (const float*)(ws + WS_ADA) + (size_t)modrow_of_tile(u.pm) * NADA;
        const int c0 = u.pn * 256 + 32 * wc + 8 * fq;
        f32x4 g2[2][2];
#pragma unroll
        for (int bj = 0; bj < 2; ++bj)
#pragma unroll
            for (int n = 0; n < 2; ++n) g2[bj][n] = *(const f32x4*)(ada + 5120 + c0 + 128 * bj + 4 * n);
#pragma unroll
        for (int ai = 0; ai < 2; ++ai) {
            f32x4 yv[4][2][2];
#pragma unroll
            for (int m = 0; m < 4; ++m) { const float* yr = out + (size_t)(u.pm * 256 + 128 * ai + 64 * wr + 16 * m + fr) * DM + c0;
#pragma unroll
                for (int bj = 0; bj < 2; ++bj)
#pragma unroll
                    for (int n = 0; n < 2; ++n) yv[m][bj][n] = *(const f32x4*)(yr + 128 * bj + 4 * n); }
#pragma unroll
            for (int m = 0; m < 4; ++m) { float* yr = out + (size_t)(u.pm * 256 + 128 * ai + 64 * wr + 16 * m + fr) * DM + c0;
#pragma unroll
                for (int bj = 0; bj < 2; ++bj)
#pragma unroll
                    for (int n = 0; n < 2; ++n) *(f32x4*)(yr + 128 * bj + 4 * n) = yv[m][bj][n] + g2[bj][n] * acc[ai][bj][m][n]; }
        }
    }
};
struct OneUnitSched {
    int has; Unit u0;
    __device__ __forceinline__ bool next(int i, Unit& u) const { if (i > 0 || !has) return false; u = u0; return true; }
    __device__ __forceinline__ void a_ready(const Unit&) const {}
    __device__ __forceinline__ void done(const Unit&) const {}
};

__device__ __forceinline__ float bf_lo(unsigned w) { return __uint_as_float(w << 16); }
__device__ __forceinline__ float bf_hi(unsigned w) { return __uint_as_float(w & 0xffff0000u); }
__device__ __forceinline__ void p6_act(const Params& P, int tid, int G) {
    const bf16_t* Gb = (const bf16_t*)(P.ws + WS_G); bf16_t* Ub = (bf16_t*)(P.ws + WS_U);
    constexpr int CG = DFF / 8, RPC = 36;
    const int gt = blockIdx.x * 512 + tid, cg = gt % CG, r0 = (gt / CG) * RPC;
    if (r0 < NTOK) {
        const int r1 = (r0 + RPC < NTOK) ? r0 + RPC : NTOK, f0 = cg * 8;
        float w0[8], w1[8], w2[8], cb[8];
        { const f32x4 a0 = *(const f32x4*)(P.conv_w + f0), a1 = *(const f32x4*)(P.conv_w + f0 + 4), b0 = *(const f32x4*)(P.conv_w + DFF + f0), b1 = *(const f32x4*)(P.conv_w + DFF + f0 + 4);
          const f32x4 c0 = *(const f32x4*)(P.conv_w + 2 * DFF + f0), c1 = *(const f32x4*)(P.conv_w + 2 * DFF + f0 + 4), d0 = *(const f32x4*)(P.conv_b + f0), d1 = *(const f32x4*)(P.conv_b + f0 + 4);
#pragma unroll
          for (int i = 0; i < 4; ++i) { w0[i] = a0[i]; w0[4 + i] = a1[i]; w1[i] = b0[i]; w1[4 + i] = b1[i]; w2[i] = c0[i]; w2[4 + i] = c1[i]; cb[i] = d0[i]; cb[4 + i] = d1[i]; } }
        const u32x4 zero = {0u, 0u, 0u, 0u};
        u32x4 gp = r0 > 0 ? *(const u32x4*)(Gb + (size_t)(r0 - 1) * DFF + f0) : zero;
        u32x4 gc = *(const u32x4*)(Gb + (size_t)r0 * DFF + f0);
        for (int r = r0; r < r1; r += 4) {
            u32x4 gn[4], uu[4];
#pragma unroll
            for (int i = 0; i < 4; ++i) { const int rn = (r + 1 + i < NTOK) ? r + 1 + i : NTOK - 1; gn[i] = *(const u32x4*)(Gb + (size_t)rn * DFF + f0); uu[i] = *(const u32x4*)(Ub + (size_t)(r + i) * DFF + f0); }
#pragma unroll
            for (int i = 0; i < 4; ++i) { const int rr = r + i; const int sl = rr < NTOK_P ? (rr & 255) : ((rr - NTOK_P) & 1023); const int last = rr < NTOK_P ? 255 : 1023;
                const u32x4 gl = sl > 0 ? gp : zero, gr = sl < last ? gn[i] : zero;
                float res[8];
#pragma unroll
                for (int q = 0; q < 4; ++q) {
                    const float xl = bf_lo(gl[q]) * w0[2 * q] + bf_lo(gc[q]) * w1[2 * q] + bf_lo(gr[q]) * w2[2 * q] + cb[2 * q];
                    const float xh = bf_hi(gl[q]) * w0[2 * q + 1] + bf_hi(gc[q]) * w1[2 * q + 1] + bf_hi(gr[q]) * w2[2 * q + 1] + cb[2 * q + 1];
                    res[2 * q] = xl / (1.0f + __expf(-xl)) * bf_lo(uu[i][q]); res[2 * q + 1] = xh / (1.0f + __expf(-xh)) * bf_hi(uu[i][q]); }
                u32x4 o; o.x = pk2(res[0], res[1]); o.y = pk2(res[2], res[3]); o.z = pk2(res[4], res[5]); o.w = pk2(res[6], res[7]);
                *(u32x4*)(Ub + (size_t)rr * DFF + f0) = o;
                gp = gc; gc = gn[i]; }
        }
    }
}
constexpr int N_PHASES = 8;
constexpr int N_LAUNCHES = MK_N_LAUNCHES;
struct StridedSched {
    int n, first, stride, npm;
    __device__ __forceinline__ bool next(int i, Unit& u) const { const int idx = first + i * stride; if (idx >= n) return false; u.pm = idx % npm; u.pn = idx / npm; return true; }
    __device__ __forceinline__ void a_ready(const Unit&) const {}
    __device__ __forceinline__ void done(const Unit&) const {}
};
__device__ __forceinline__ bool attn_next(int vcu, int G, int i, int& kind, int& idx) {
    if (G == 256) {
        if (vcu < 128) { if (i >= 2) return false; kind = 0; idx = 2 * vcu + i; return true; }
        const int v = vcu - 128;
        if (i == 0) { kind = 0; idx = 256 + v; return true; }
        if (v < 64 || i > 3) return false;
        kind = 1; idx = 3 * (v - 64) + i - 1; return true;
    }
    const int l = vcu + i * G; if (l >= 576) return false;
    if (l < 384) { kind = 0; idx = l; } else { kind = 1; idx = l - 384; }
    return true;
}
__global__ void __launch_bounds__(NWAVES * 64, 2) mk_fwd(Params P) {
    extern __shared__ __attribute__((aligned(16))) unsigned char lds_raw[];
    LAS unsigned char* lds = (LAS unsigned char*)lds_raw;
    const int tid = threadIdx.x, lane = tid & 63, wave = __builtin_amdgcn_readfirstlane(tid >> 6);
    const int G = gridDim.x, bx = blockIdx.x, vcu = (G % 8 == 0) ? (bx % 8) * (G / 8) + bx / 8 : bx;
    volatile LAS unsigned* MISC = (volatile LAS unsigned*)(lds + MISC_OFF);
    unsigned char* ws = P.ws;
    unsigned* ctl = (unsigned*)(ws + WS_CTL);
    for (int u = tid; u < (LDS_BYTES - LDSCTL_OFF) / 4; u += NWAVES * 64) ((LAS unsigned*)(lds + LDSCTL_OFF))[u] = 0u;
    __syncthreads();
    XcdBarrier bar; bar.bar = ctl + CW_BAR + P.li * XCD_BAR_WORDS; bar.x = 0; bar.st = nullptr;
    if (N_LAUNCHES != N_PHASES) bar = xcd_barrier_post(ctl + CW_BAR + P.li * XCD_BAR_WORDS, MISC + 8);
#define GRID_BAR() do { if (N_LAUNCHES != N_PHASES) xcd_barrier(bar); } while (0)
    const int lo = P.ph_lo, hi = P.ph_hi;
#ifndef PHASE_MASK
#define PHASE_MASK 0xff
#endif
#define IN(k) (((PHASE_MASK >> (k)) & 1) && lo <= (k) && (k) < hi)
#define BOTH(k) (IN(k) && IN((k) + 1))

    if (IN(0)) { p0_prep(P, lds, tid, lane, wave, vcu, G); if (BOTH(0)) GRID_BAR(); }
    if (IN(1)) { p1_norm(P, lds, tid, lane, wave, vcu, G); if (BOTH(1)) GRID_BAR(); }
    if (IN(2)) {
        pg8::Gemm g{(const bf16_t*)(ws + WS_H), (const bf16_t*)(ws + WS_WIN), NTOK, DIN, DM}; pg8::StaticOrder S; S.init(NTOK, DIN, G, bx);
        EpiInProj E{ws, P.out + (size_t)NTOK * DM, P.out + (size_t)NTOK * DM + (size_t)16 * NH * SP * 128, P.qg, P.kg};
        pg8::gemm_phase<EpiInProj, pg8::StaticOrder, true, true>(lds + RING_OFF, g, S, E);
        if (BOTH(2)) GRID_BAR();
    }
    if (IN(3)) {
        float lam, negref;
        { const float a = wave_sum(P.lq1[lane] * P.lk1[lane]), b2 = wave_sum(P.lq2[lane] * P.lk2[lane]); lam = expf(a) - expf(b2) + LAM_INIT;
          const float gq = wave_max(fabsf(P.qg[lane])), gk = wave_max(fabsf(P.kg[lane]));
          const float kmax2 = __uint_as_float(__hip_atomic_load(ctl + CW_KMAX, RLX_AGENT)); const float kmax = fmaxf(8.0f * gk, sqrtf(kmax2));
          negref = -(C2 * 8.0f * gq * kmax * 1.01f + 0.25f); }
#ifndef ATTN_OFF
        for (int i = 0; ; ++i) {
            int kind, idx; if (!attn_next(vcu, G, i, kind, idx)) break;
            const int bh = kind ? idx >> 1 : idx >> 3, qb = kind ? idx & 1 : idx & 7, b = bh / NH, h = bh - b * NH;
            const int Sq = kind ? SP : SS, Sk = kind ? SP : SKS;
            const bf16_t* Qh = (const bf16_t*)(ws + (kind ? WS_Q_P : WS_Q_S)) + (size_t)bh * 2 * Sq * 64;
            const bf16_t* Kh = (const bf16_t*)(ws + (kind ? WS_K_P : WS_K_S)) + (size_t)bh * 2 * Sk * 64;
            const bf16_t* Vh = (const bf16_t*)(ws + (kind ? WS_V_P : WS_V_S)) + (size_t)bh * Sk * 128;
            bf16_t* outp = (bf16_t*)(ws + WS_MIX) + (size_t)((kind ? 0 : NTOK_P) + b * Sq) * KOUT + 512 + h * 128;
            attn::attn_unit(lds, Qh, Kh, Vh, Sq, Sk, qb * 128, outp, lam, negref, P.subg);
        }
#endif
#ifndef FOURIER_OFF
        __syncthreads();
        { pg8::Gemm g{(const bf16_t*)(ws + WS_DFTS), (const bf16_t*)(ws + WS_XFT_S), 2048, 2048, SS};
          StridedSched S = (G == 256) ? StridedSched{64, (vcu >= 128 && vcu < 192) ? vcu - 128 : 64, 64, 8} : StridedSched{64, vcu, G, 8};
          EpiFourier E{(bf16_t*)(ws + WS_MIX), SS, NTOK_P};
          pg8::gemm_phase<EpiFourier, StridedSched, true, true>(lds + RING_OFF, g, S, E); }
        __syncthreads();
        { pg8::Gemm g{(const bf16_t*)(ws + WS_DFTP), (const bf16_t*)(ws + WS_XFT_P), 512, 4096, SP};
          StridedSched S = (G == 256) ? StridedSched{32, (vcu >= 192 && vcu < 224) ? vcu - 192 : 32, 32, 2} : StridedSched{32, vcu, G, 2};
          EpiFourier E{(bf16_t*)(ws + WS_MIX), SP, 0};
          pg8::gemm_phase<EpiFourier, StridedSched, true, true>(lds + RING_OFF, g, S, E); }
#endif
        if (BOTH(3)) GRID_BAR();
    }
    if (IN(4)) {
        pg8::Gemm g{(const bf16_t*)(ws + WS_MIX), (const bf16_t*)(ws + WS_WOUT), NTOK, DM, KOUT}; pg8::StaticOrder S; S.init(NTOK, DM, G, bx);
        EpiOut E{P};
        pg8::gemm_phase<EpiOut, pg8::StaticOrder, true, true>(lds + RING_OFF, g, S, E);
        if (BOTH(4)) GRID_BAR();
    }
    if (IN(5)) {
        pg8::Gemm g{(const bf16_t*)(ws + WS_H), (const bf16_t*)(ws + WS_WGU), NTOK, NGU, DM}; pg8::StaticOrder S; S.init(NTOK, NGU, G, bx);
        EpiGU E{ws};
        pg8::gemm_phase<EpiGU, pg8::StaticOrder, true, true>(lds + RING_OFF, g, S, E);
        if (BOTH(5)) GRID_BAR();
    }
    if (IN(6)) { p6_act(P, tid, G); if (BOTH(6)) GRID_BAR(); }
    if (IN(7)) {
        pg8::Gemm g{(const bf16_t*)(ws + WS_U), (const bf16_t*)(ws + WS_WDN), NTOK, DM, DFF}; pg8::StaticOrder S; S.init(NTOK, DM, G, bx);
        EpiDown E{ws, P.out};
        pg8::gemm_phase<EpiDown, pg8::StaticOrder, true, true>(lds + RING_OFF, g, S, E);
    }
#undef IN
#undef BOTH
#undef GRID_BAR
}

extern "C" void kernel_launch(void* const* d_in, const int* in_sizes, int n_in, void* d_out, int out_size, void* d_ws, size_t ws_size, hipStream_t stream) {
    static int ok = 0;
    if (ok == 0) {
        if (n_in != 24 || ws_size < WS_END) { fprintf(stderr, "kernel_launch: expected 24 inputs and >= %zu bytes of workspace; got %d, %zu\n", (size_t)WS_END, n_in, ws_size); ok = -1; return; }
        if (hipFuncSetAttribute((const void*)mk_fwd, hipFuncAttributeMaxDynamicSharedMemorySize, LDS_BYTES) != hipSuccess) { fprintf(stderr, "kernel_launch: hipFuncSetAttribute failed\n"); ok = -1; return; }
        int per_cu = 0;
        if (hipOccupancyMaxActiveBlocksPerMultiprocessor(&per_cu, (const void*)mk_fwd, NWAVES * 64, LDS_BYTES) != hipSuccess || per_cu < 1) fprintf(stderr, "kernel_launch: note: occupancy query reports %d workgroups per CU\n", per_cu);
        (void)hipGetLastError();
        ok = 1;
    }
    if (ok < 0) return;
    (void)hipMemsetAsync((char*)d_ws + WS_CTL, 0, CTL_ZERO_BYTES, stream);
    Params a{};
    const float** pp = (const float**)&a;
    for (int i = 0; i < 24; ++i) pp[i] = (const float*)d_in[i];
    a.out = (float*)d_out; a.ws = (unsigned char*)d_ws;
#ifdef PROBE_PHASE
    const int nl = 2; const int plo[2] = {0, PROBE_PHASE}, phi[2] = {PROBE_PHASE + 1, N_PHASES};
#else
    const int nl = N_LAUNCHES; int plo[N_PHASES], phi[N_PHASES];
    for (int li = 0; li < N_LAUNCHES; ++li) { plo[li] = (N_LAUNCHES == 1) ? 0 : li; phi[li] = (N_LAUNCHES == 1) ? N_PHASES : li + 1; }
#endif
    for (int li = 0; li < nl; ++li) {
        a.ph_lo = plo[li]; a.ph_hi = phi[li]; a.li = li; a.pad = 0;
        hipLaunchKernelGGL(mk_fwd, dim3(256), dim3(NWAVES * 64), LDS_BYTES, stream, a);
        const hipError_t le = hipPeekAtLastError();
        if (le != hipSuccess) { fprintf(stderr, "kernel_launch: launch %d failed: %s\n", li, hipGetErrorName(le)); break; }
    }
}
```

```cpp
#include <hip/hip_runtime.h>
#include <cstdio>
#include <cstdint>

#ifndef MK_N_LAUNCHES
#define MK_N_LAUNCHES 1
#endif
#define LAS __attribute__((address_space(3)))
#define GAS __attribute__((address_space(1)))
typedef unsigned short bf16_t;
typedef short bf16x8 __attribute__((ext_vector_type(8)));
typedef short s16x4 __attribute__((ext_vector_type(4)));
typedef float f32x2 __attribute__((ext_vector_type(2)));
typedef float f32x4 __attribute__((ext_vector_type(4)));
typedef float f32x16 __attribute__((ext_vector_type(16)));
typedef unsigned u32x2 __attribute__((ext_vector_type(2)));
typedef unsigned u32x4 __attribute__((ext_vector_type(4)));
typedef __bf16 bf16x2_t __attribute__((ext_vector_type(2)));
typedef GAS unsigned gu32;
#define RLX_AGENT __ATOMIC_RELAXED, __HIP_MEMORY_SCOPE_AGENT
#define LDS_WAIT() asm volatile("s_waitcnt lgkmcnt(0)" ::: "memory")
#define VM_WAIT() asm volatile("s_waitcnt vmcnt(0)" ::: "memory")
__device__ __forceinline__ unsigned pk2(float lo, float hi) { f32x2 v = {lo, hi}; bf16x2_t b = __builtin_convertvector(v, bf16x2_t); return __builtin_bit_cast(unsigned, b); }
__device__ __forceinline__ bf16_t f2bf(float x) { return (bf16_t)(pk2(x, 0.f) & 0xffffu); }
__device__ __forceinline__ float wave_sum(float v) {
#pragma unroll
    for (int o = 1; o < 64; o <<= 1) v += __shfl_xor(v, o);
    return v;
}
__device__ __forceinline__ float wave_max(float v) {
#pragma unroll
    for (int o = 1; o < 64; o <<= 1) v = fmaxf(v, __shfl_xor(v, o));
    return v;
}

constexpr int DM = 1024, NTOK = 12288, NTOK_P = 4096, NH = 6;
constexpr int SP = 256, SS = 1024, SKS = 1536, PAST = 512;
constexpr int DIN = 2560, DFF = 2816, KOUT = 1280, NGU = 5632, NADA = 6144;
constexpr float EPS = 1e-6f;
constexpr float C2 = 0.125f * 1.4426950408889634f;
constexpr float ONE_M_LAMINIT = 0.8f, LAM_INIT = 0.2f;

constexpr size_t MiB = 1u << 20;
constexpr size_t WS_CTL = 0, CTL_ZERO_BYTES = 1 * MiB;
constexpr size_t WS_ADA = 1 * MiB;
constexpr size_t WS_BIAS2 = 1 * MiB + 256 * 1024;
constexpr size_t WS_ROPE = 1 * MiB + 512 * 1024;
constexpr size_t WS_SSQ = 2 * MiB;
constexpr size_t WS_WIN = 3 * MiB;
constexpr size_t WS_WOUT = 8 * MiB;
constexpr size_t WS_WGU = 11 * MiB;
constexpr size_t WS_WDN = 22 * MiB;
constexpr size_t WS_DFTS = 28 * MiB;
constexpr size_t WS_DFTP = 32 * MiB;
constexpr size_t WS_H = 33 * MiB;
constexpr size_t WS_XFT_P = 58 * MiB, WS_XFT_S = 60 * MiB;
constexpr size_t WS_Q_P = 64 * MiB, WS_Q_S = 70 * MiB;
constexpr size_t WS_K_P = 82 * MiB, WS_K_S = 88 * MiB;
constexpr size_t WS_V_P = 106 * MiB, WS_V_S = 112 * MiB;
constexpr size_t WS_MIX = 130 * MiB;
constexpr size_t WS_G = 58 * MiB, WS_U = 124 * MiB;
constexpr size_t WS_X1 = 190 * MiB;
constexpr size_t WS_END = 238 * MiB;
constexpr int CW_TMO = 0, CW_CODE = 1, CW_KMAX = 64, CW_BAR = 4096;

constexpr int RING_OFF = 0, RING_BYTES = 131072;
constexpr int ATT_WSC_OFF = RING_BYTES;
constexpr int LDSCTL_OFF = RING_BYTES + 2048, MISC_OFF = LDSCTL_OFF + 320;
constexpr int LDS_BYTES = 147456;
constexpr int NWAVES = 8;
namespace pg8 {
#define PG8_LAS __attribute__((address_space(3)))
typedef unsigned short bf16_t;
typedef short bf16x8 __attribute__((ext_vector_type(8)));
typedef float f32x4 __attribute__((ext_vector_type(4)));
typedef unsigned u32x4 __attribute__((ext_vector_type(4)));
constexpr int BM = 256, BK = 64, HALF = 128, HTB = HALF * BK * 2  , STAGE_BYTES = 8 * HTB, NXCD = 8, WGM = 8;

__host__ __device__ __forceinline__ int lds_byte(int r, int c) { const int st = (r >> 4) * 2 + (c >> 5), rr = r & 15, cc = c & 31, ob = rr * 64 + cc * 2; return st * 1024 + (ob ^ (((ob >> 9) & 1) << 5)); }
__host__ __device__ __forceinline__ void stage_rc(int b, int& R, int& C) { const int st = b / 1024, sb = b % 1024, swz = sb ^ (((sb >> 9) & 1) << 5); R = (st >> 1) * 16 + swz / 64; C = (st & 1) * 32 + (swz % 64) / 2; }
__host__ __device__ __forceinline__ int perm32(int rho) { const int n = rho >> 4, i = rho & 15; return 8 * (i >> 2) + 4 * n + (i & 3); }

struct Unit { int pm, pn; };
struct Gemm { const bf16_t* A; const bf16_t* Bt; int M, N, K; };

struct StaticOrder {
    int nM, nN, nwg, G, c;
    __host__ __device__ void init(int M, int N, int G_, int c_) { nM = M / BM; nN = N / BM; nwg = nM * nN; G = G_; c = c_; }
    __host__ __device__ bool next(int i, Unit& u) const {
        const long L = (long)i * G + c; if (L >= nwg) return false;
        int wgid = (int)L; { const int q = nwg / NXCD, r = nwg % NXCD, xcd = wgid % NXCD, off = wgid / NXCD; wgid = (xcd < r ? xcd * (q + 1) : r * (q + 1) + (xcd - r) * q) + off; }
        const int nig = WGM * nN, gid = wgid / nig, fm = gid * WGM, gsz = (nM - fm) < WGM ? (nM - fm) : WGM;
        u.pm = fm + ((wgid % nig) % gsz); u.pn = (wgid % nig) / gsz; return true;
    }
    __device__ __forceinline__ void a_ready(const Unit&) const {}
    __device__ __forceinline__ void done(const Unit&) const {}
};

__device__ __forceinline__ unsigned cvt_pk_bf16(float lo, float hi) { unsigned r; asm volatile("v_cvt_pk_bf16_f32 %0, %1, %2" : "=v"(r) : "v"(lo), "v"(hi)); return r; }
template <class Epi, class Sched, bool ALIGN_EPI = false, bool SP2 = false>
__device__ __forceinline__ void gemm_phase(PG8_LAS unsigned char* lds, const Gemm g, const Sched& S, const Epi& E) {
    const int tid = threadIdx.x, wid = __builtin_amdgcn_readfirstlane(tid >> 6), lane = tid & 63, wr = wid >> 2, wc = wid & 3, fr = lane & 15, fq = lane >> 4;
    const int K = g.K, nt = K / BK;
    unsigned voffA[2], voffB[2];
#pragma unroll
    for (int i = 0; i < 2; ++i) { int R, C; stage_rc(tid * 16 + i * 8192, R, C); const int Rb = Epi::PERM ? ((R & ~31) + perm32(R & 31)) : R;
        voffA[i] = (unsigned)(R * K + C) * 2u; voffB[i] = (unsigned)(Rb * K + C) * 2u; }
    const size_t kstep = (size_t)(BK * 2);
    const size_t hstep = (size_t)HALF * K * 2;
    const size_t tstep = 2 * hstep;
    const unsigned ldsw = (unsigned)wid * 1024u;
    const int aoff = lds_byte(wr * 64 + fr, fq * 8), boff = lds_byte(wc * 32 + fr, fq * 8);
#define PG8_SA(b, h) (((b) * 2 + (h)) * HTB)
#define PG8_SB(b, h) ((4 + (b) * 2 + (h)) * HTB)
#define PG8_STAGE(bufoff, gbase, voff) do { _Pragma("unroll") for (int _i = 0; _i < 2; ++_i) \
        __builtin_amdgcn_global_load_lds((const unsigned*)((const char*)(gbase) + (voff)[_i]), (PG8_LAS unsigned*)(lds + (bufoff) + ldsw + _i * 8192), 16, 0, 0); } while (0)
#define PG8_LDA(dst, b, h) do { _Pragma("unroll") for (int m = 0; m < 4; ++m) _Pragma("unroll") for (int k = 0; k < 2; ++k) dst[m][k] = *(const PG8_LAS bf16x8*)(lds + PG8_SA(b, h) + aoff + m * 2048 + k * 1024); } while (0)
#define PG8_LDB(dst, b, h) do { _Pragma("unroll") for (int n = 0; n < 2; ++n) _Pragma("unroll") for (int k = 0; k < 2; ++k) dst[n][k] = *(const PG8_LAS bf16x8*)(lds + PG8_SB(b, h) + boff + n * 2048 + k * 1024); } while (0)
#define PG8_MMA(ai, bj, At, Bt) do { __builtin_amdgcn_s_setprio(1); _Pragma("unroll") for (int m = 0; m < 4; ++m) _Pragma("unroll") for (int n = 0; n < 2; ++n) _Pragma("unroll") for (int k = 0; k < 2; ++k) \
        acc[ai][bj][m][n] = __builtin_amdgcn_mfma_f32_16x16x32_bf16(Bt[n][k], At[m][k], acc[ai][bj][m][n], 0, 0, 0); __builtin_amdgcn_s_setprio(0); } while (0)
#define PG8_WAIT_V(n) asm volatile("s_waitcnt vmcnt(" #n ")" ::: "memory")
#define PG8_WAIT_L(n) asm volatile("s_waitcnt lgkmcnt(" #n ")" ::: "memory")
#define PG8_BAR __builtin_amdgcn_s_barrier()
#define PG8_SCHED __builtin_amdgcn_sched_barrier(0)
    Unit cur, nxt; int ui = 0;
    if (!S.next(0, cur)) return;
    f32x4 acc[2][2][4][2];
#pragma unroll
    for (int a = 0; a < 2; ++a)
#pragma unroll
        for (int b = 0; b < 2; ++b)
#pragma unroll
            for (int m = 0; m < 4; ++m)
#pragma unroll
                for (int n = 0; n < 2; ++n) acc[a][b][m][n] = (f32x4){0.f, 0.f, 0.f, 0.f};
    bf16x8 At[4][2], B0[2][2], B1[2][2];
    const char* cA = (const char*)g.A + (size_t)cur.pm * tstep; const char* cB = (const char*)g.Bt + (size_t)cur.pn * tstep;
    S.a_ready(cur);
    if constexpr (SP2) {
        PG8_STAGE(PG8_SB(0, 0), cB, voffB); PG8_STAGE(PG8_SB(0, 1), cB + hstep, voffB); PG8_STAGE(PG8_SA(0, 0), cA, voffA); PG8_STAGE(PG8_SA(0, 1), cA + hstep, voffA);
        if (wr == 1) PG8_BAR;
        PG8_WAIT_V(2); PG8_BAR;
        PG8_STAGE(PG8_SB(1, 0), cB + kstep, voffB); PG8_STAGE(PG8_SA(1, 0), cA + kstep, voffA); PG8_STAGE(PG8_SB(1, 1), cB + hstep + kstep, voffB);
        PG8_WAIT_V(6); PG8_BAR;
    } else {
        PG8_STAGE(PG8_SB(0, 0), cB, voffB); PG8_STAGE(PG8_SA(0, 0), cA, voffA); PG8_STAGE(PG8_SB(0, 1), cB + hstep, voffB); PG8_STAGE(PG8_SA(0, 1), cA + hstep, voffA);
        if (wr == 1) PG8_BAR;
        PG8_WAIT_V(4); PG8_BAR;
        PG8_STAGE(PG8_SB(1, 0), cB + kstep, voffB); PG8_STAGE(PG8_SA(1, 0), cA + kstep, voffA); PG8_STAGE(PG8_SB(1, 1), cB + hstep + kstep, voffB);
        PG8_WAIT_V(6); PG8_BAR;
    }
    for (;;) {
        const bool has_next = S.next(ui + 1, nxt);
        const char* nA = has_next ? (const char*)g.A + (size_t)nxt.pm * tstep : cA; const char* nB = has_next ? (const char*)g.Bt + (size_t)nxt.pn * tstep : cB;
        for (int t = 0; t < nt; t += 2) {
            const bool last = (t == nt - 2);
            const char* a1 = cA + (size_t)(t + 1) * kstep;
            const char* a2 = last ? nA : cA + (size_t)(t + 2) * kstep; const char* b2 = last ? nB : cB + (size_t)(t + 2) * kstep;
            const char* a3 = a2 + kstep; const char* b3 = b2 + kstep;
            if (last && has_next) S.a_ready(nxt);
            if constexpr (SP2) {
            PG8_LDB(B0, 0, 0); PG8_LDB(B1, 0, 1); PG8_SCHED; PG8_LDA(At, 0, 0); PG8_STAGE(PG8_SA(1, 1), a1 + hstep, voffA);
            PG8_WAIT_V(8); PG8_WAIT_L(0); PG8_BAR; PG8_MMA(0, 0, At, B0); PG8_MMA(0, 1, At, B1); PG8_BAR; PG8_SCHED;
            PG8_LDA(At, 0, 1); PG8_STAGE(PG8_SB(0, 0), b2, voffB); PG8_STAGE(PG8_SB(0, 1), b2 + hstep, voffB); PG8_STAGE(PG8_SA(0, 0), a2, voffA);
            PG8_WAIT_V(8); PG8_WAIT_L(0); PG8_BAR; PG8_MMA(1, 0, At, B0); PG8_MMA(1, 1, At, B1); PG8_BAR; PG8_SCHED;
            PG8_LDB(B0, 1, 0); PG8_LDB(B1, 1, 1); PG8_SCHED; PG8_LDA(At, 1, 0); PG8_STAGE(PG8_SA(0, 1), a2 + hstep, voffA);
            PG8_WAIT_V(8); PG8_WAIT_L(0); PG8_BAR; PG8_MMA(0, 0, At, B0); PG8_MMA(0, 1, At, B1); PG8_BAR; PG8_SCHED;
            PG8_LDA(At, 1, 1); PG8_STAGE(PG8_SB(1, 0), b3, voffB); PG8_STAGE(PG8_SB(1, 1), b3 + hstep, voffB); PG8_STAGE(PG8_SA(1, 0), a3, voffA);
            PG8_WAIT_V(8); PG8_WAIT_L(0); PG8_BAR; PG8_MMA(1, 0, At, B0); PG8_MMA(1, 1, At, B1); PG8_BAR; PG8_SCHED;
            } else {
            PG8_LDB(B0, 0, 0); PG8_SCHED; PG8_LDA(At, 0, 0); PG8_STAGE(PG8_SA(1, 1), a1 + hstep, voffA);
            PG8_WAIT_L(8); PG8_BAR; PG8_WAIT_L(0); PG8_MMA(0, 0, At, B0); PG8_BAR; PG8_SCHED;
            PG8_LDB(B1, 0, 1); PG8_STAGE(PG8_SB(0, 0), b2, voffB);
            PG8_BAR; PG8_WAIT_L(0); PG8_MMA(0, 1, At, B1); PG8_BAR;
            PG8_LDA(At, 0, 1); PG8_STAGE(PG8_SA(0, 0), a2, voffA);
            PG8_BAR; PG8_WAIT_L(0); PG8_MMA(1, 0, At, B0); PG8_BAR; PG8_SCHED;
            PG8_STAGE(PG8_SB(0, 1), b2 + hstep, voffB);
            PG8_WAIT_V(6); PG8_BAR; PG8_MMA(1, 1, At, B1); PG8_BAR;
            PG8_LDB(B0, 1, 0); PG8_SCHED; PG8_LDA(At, 1, 0); PG8_STAGE(PG8_SA(0, 1), a2 + hstep, voffA);
            PG8_WAIT_L(8); PG8_BAR; PG8_WAIT_L(0); PG8_MMA(0, 0, At, B0); PG8_BAR; PG8_SCHED;
            PG8_LDB(B1, 1, 1); PG8_STAGE(PG8_SB(1, 0), b3, voffB);
            PG8_BAR; PG8_WAIT_L(0); PG8_MMA(0, 1, At, B1); PG8_BAR;
            PG8_LDA(At, 1, 1); PG8_STAGE(PG8_SA(1, 0), a3, voffA);
            PG8_BAR; PG8_WAIT_L(0); PG8_MMA(1, 0, At, B0); PG8_BAR; PG8_SCHED;
            PG8_STAGE(PG8_SB(1, 1), b3 + hstep, voffB);
            PG8_WAIT_V(6); PG8_BAR; PG8_MMA(1, 1, At, B1); PG8_BAR;
            }
        }
        if constexpr (ALIGN_EPI) { if (wr == 0) PG8_BAR; }
        if constexpr (!Epi::AFTER_DRAIN) { E(acc, cur, wr, wc, fr, fq); S.done(cur); }
        if (!has_next) break;
#pragma unroll
        for (int a = 0; a < 2; ++a)
#pragma unroll
            for (int b = 0; b < 2; ++b)
#pragma unroll
                for (int m = 0; m < 4; ++m)
#pragma unroll
                    for (int n = 0; n < 2; ++n) acc[a][b][m][n] = (f32x4){0.f, 0.f, 0.f, 0.f};
        cur = nxt; cA = nA; cB = nB; ++ui;
        if constexpr (ALIGN_EPI) { if (wr == 1) PG8_BAR; }
    }
    PG8_WAIT_V(0);
    if constexpr (!ALIGN_EPI) { if (wr == 0) PG8_BAR; }
    PG8_BAR;
    if constexpr (Epi::AFTER_DRAIN) { E.fused(acc, cur, wr, wc, fr, fq, lds, wid, lane); S.done(cur); }
#undef PG8_SA
#undef PG8_SB
#undef PG8_STAGE
#undef PG8_LDA
#undef PG8_LDB
#undef PG8_MMA
#undef PG8_WAIT_V
#undef PG8_WAIT_L
#undef PG8_BAR
#undef PG8_SCHED
}
}
#define XB_TMO      128
#define XB_XCNT(j)  (256  + 64 * (j))
#define XB_XSUB(j)  (1280 + 64 * (j))
#define XB_XGEN(j)  (2304 + 64 * (j))
#define XB_TOP      3328
#define XB_TOPGEN   3392
#define XCD_BAR_WORDS 3456
#define XB_SPIN_CAP (1u << 18)

__device__ __forceinline__ unsigned xb_ld(unsigned* p)              { return __hip_atomic_load(p, __ATOMIC_RELAXED, __HIP_MEMORY_SCOPE_AGENT); }
__device__ __forceinline__ unsigned xb_add(unsigned* p, unsigned v) { return __hip_atomic_fetch_add(p, v, __ATOMIC_RELAXED, __HIP_MEMORY_SCOPE_AGENT); }
__device__ __forceinline__ unsigned xb_xcc_id() { return (unsigned)__builtin_amdgcn_s_getreg((3 << 11) | 20) & 0xFu; }
#define XB_SPIN(cond, bar) do { unsigned _sp = 0; while (cond) { __builtin_amdgcn_s_sleep(1); \
    if ((++_sp & 255u) == 0u) { if (xb_ld(&(bar)[XB_TMO])) break; if (_sp > XB_SPIN_CAP) { atomicAdd(&(bar)[XB_TMO], 1u); break; } } } } while (0)

struct XcdBarrier {
    unsigned* bar; unsigned x;
    volatile LAS unsigned* st;
};

__device__ __forceinline__ XcdBarrier xcd_barrier_post(unsigned* bar, volatile LAS unsigned* st) {
    XcdBarrier b; b.bar = bar; b.x = xb_xcc_id(); b.st = st;
    if (threadIdx.x == 0) (void)xb_add(&bar[XB_XCNT(b.x)], 1u);
    return b;
}
__device__ __forceinline__ void xcd_barrier_complete(unsigned* bar, unsigned x, unsigned& nloc, unsigned& nx) {
    const unsigned G = gridDim.x * gridDim.y * gridDim.z;
    unsigned sum, cnt, mine, sp = 0u;
    for (;;) {
        sum = 0u; cnt = 0u; mine = 0u;
#pragma unroll
        for (unsigned j = 0; j < 16; ++j) { const unsigned c = xb_ld(&bar[XB_XCNT(j)]); sum += c; cnt += (c > 0u) ? 1u : 0u; mine = (j == x) ? c : mine; }
        if (sum == G) break;
        __builtin_amdgcn_s_sleep(1);
        if ((++sp & 255u) == 0u) { if (xb_ld(&bar[XB_TMO])) break; if (sp > XB_SPIN_CAP) { atomicAdd(&bar[XB_TMO], 1u); break; } }
    }
    nloc = mine > 0u ? mine : 1u; nx = cnt > 0u ? cnt : 1u;
}

__device__ __forceinline__ void xcd_barrier(const XcdBarrier& b) {
    asm volatile("s_waitcnt vmcnt(0)" ::: "memory");
    __syncthreads();
    if (threadIdx.x == 0) {
        unsigned* bar = b.bar;
        __builtin_amdgcn_s_waitcnt(0);
        unsigned nloc = b.st[0], nx = b.st[1];
        if (nloc == 0u) { xcd_barrier_complete(bar, b.x, nloc, nx); b.st[0] = nloc; b.st[1] = nx; }
        const unsigned old = xb_add(&bar[XB_XSUB(b.x)], 1u);
        const unsigned gen = old / nloc;
        if (old + 1u == (gen + 1u) * nloc) {
            __builtin_amdgcn_fence(__ATOMIC_RELEASE, "agent");
            asm volatile("s_waitcnt vmcnt(0)" ::: "memory");
            const unsigned og = xb_add(&bar[XB_TOP], 1u);
            const unsigned tg = og / nx;
            if (og + 1u == (tg + 1u) * nx) xb_add(&bar[XB_TOPGEN], 1u);
            else XB_SPIN(xb_ld(&bar[XB_TOPGEN]) == tg, bar);
            __builtin_amdgcn_fence(__ATOMIC_ACQUIRE, "agent");
            xb_add(&bar[XB_XGEN(b.x)], 1u);
            asm volatile("s_waitcnt vmcnt(0)" ::: "memory");
        } else {
            XB_SPIN(xb_ld(&bar[XB_XGEN(b.x)]) == gen, bar);
            __builtin_amdgcn_fence(__ATOMIC_ACQUIRE, "agent");
            asm volatile("s_waitcnt vmcnt(0)" ::: "memory");
        }
    }
    __syncthreads();
}
namespace attn {
constexpr int V_OFF = 0, K_OFF = 32768, EX_OFF = 65536;
#define ATT_KSWZ(row, colB) ((row) * 128 + ((colB) ^ ((((row) >> 1) & 7) << 4)))
#define ATT_SBAR() __builtin_amdgcn_sched_barrier(0)
__device__ __forceinline__ int crow(int r, int hi) { return (r & 3) + 8 * (r >> 2) + 4 * hi; }
__device__ __forceinline__ int v_st(int k, int c) { const int kk = (k & ~0xC) | ((k & 4) << 1) | ((k & 8) >> 1); return ((kk >> 3) * 4 + (c >> 5)) * 512 + ((kk & 7) * 32 + (c & 31)) * 2; }
__device__ __forceinline__ int v_rd_base(int lane) { return ((lane & 3) << 3) | (((lane >> 2) & 3) << 6) | (((lane >> 4) & 1) << 5) | (((lane >> 5) & 1) << 8); }
constexpr int v_rd_off(int d0, int ks, int half) { return d0 * 512 + ks * 4096 + half * 2048; }
template <int OFF> __device__ __forceinline__ s16x4 tr_read(int vb) {
    s16x4 r; asm volatile("ds_read_b64_tr_b16 %0, %1 offset:%2" : "=&v"(r) : "v"(vb), "i"(OFF) : "memory"); return r;
}
template <int D0> __device__ __forceinline__ void pv_one(f32x16& od, int vb, bf16x8 pa0, bf16x8 pa1, bf16x8 pa2, bf16x8 pa3) {
    const s16x4 l0 = tr_read<v_rd_off(D0, 0, 0)>(vb), h0 = tr_read<v_rd_off(D0, 0, 1)>(vb), l1 = tr_read<v_rd_off(D0, 1, 0)>(vb), h1 = tr_read<v_rd_off(D0, 1, 1)>(vb);
    const s16x4 l2 = tr_read<v_rd_off(D0, 2, 0)>(vb), h2 = tr_read<v_rd_off(D0, 2, 1)>(vb), l3 = tr_read<v_rd_off(D0, 3, 0)>(vb), h3 = tr_read<v_rd_off(D0, 3, 1)>(vb);
    asm volatile("s_waitcnt lgkmcnt(0)" ::: "memory"); ATT_SBAR();
#define ATT_PK(L, H) (bf16x8){L[0], L[1], L[2], L[3], H[0], H[1], H[2], H[3]}
    od = __builtin_amdgcn_mfma_f32_32x32x16_bf16(pa0, ATT_PK(l0, h0), od, 0, 0, 0);
    od = __builtin_amdgcn_mfma_f32_32x32x16_bf16(pa1, ATT_PK(l1, h1), od, 0, 0, 0);
    od = __builtin_amdgcn_mfma_f32_32x32x16_bf16(pa2, ATT_PK(l2, h2), od, 0, 0, 0);
    od = __builtin_amdgcn_mfma_f32_32x32x16_bf16(pa3, ATT_PK(l3, h3), od, 0, 0, 0);
#undef ATT_PK
}
__device__ __forceinline__ void pv_all(f32x16* o, int vb, bf16x8 pa0, bf16x8 pa1, bf16x8 pa2, bf16x8 pa3) {
    pv_one<0>(o[0], vb, pa0, pa1, pa2, pa3); pv_one<1>(o[1], vb, pa0, pa1, pa2, pa3); pv_one<2>(o[2], vb, pa0, pa1, pa2, pa3); pv_one<3>(o[3], vb, pa0, pa1, pa2, pa3);
}
__device__ __forceinline__ void qkt(f32x16& p0, f32x16& p1, const LAS unsigned char* Kt, const bf16x8* qr, float negref, int r32, int hi) {
#pragma unroll
    for (int r = 0; r < 16; ++r) { p0[r] = negref; p1[r] = negref; }
#pragma unroll
    for (int d0 = 0; d0 < 4; ++d0) { const int cb = (d0 * 16 + hi * 8) * 2;
        const bf16x8 b0 = *(const LAS bf16x8*)(Kt + ATT_KSWZ(r32, cb));
        const bf16x8 b1 = *(const LAS bf16x8*)(Kt + ATT_KSWZ(32 + r32, cb));
        p0 = __builtin_amdgcn_mfma_f32_32x32x16_bf16(b0, qr[d0], p0, 0, 0, 0);
        p1 = __builtin_amdgcn_mfma_f32_32x32x16_bf16(b1, qr[d0], p1, 0, 0, 0); }
}
__device__ __forceinline__ void exp_half(f32x16& p) {
#pragma unroll
    for (int r = 0; r < 16; ++r) p[r] = __builtin_amdgcn_exp2f(p[r]);
}
__device__ __forceinline__ void finish_sm(f32x16& p0, f32x16& p1, float& l_reg, bf16x8& pa0, bf16x8& pa1, bf16x8& pa2, bf16x8& pa3) {
    exp_half(p1);
    float ps = 0.f;
#pragma unroll
    for (int r = 0; r < 16; ++r) ps += p0[r];
#pragma unroll
    for (int r = 0; r < 16; ++r) ps += p1[r];
    l_reg += ps;
#define ATT_PK4(P, BASE, OUT) do { unsigned a0 = pk2(P[BASE + 0], P[BASE + 1]), a1 = pk2(P[BASE + 2], P[BASE + 3]);   \
    unsigned b0 = pk2(P[BASE + 4], P[BASE + 5]), b1 = pk2(P[BASE + 6], P[BASE + 7]);                              \
    auto r0 = __builtin_amdgcn_permlane32_swap(a0, b0, false, false); auto r1 = __builtin_amdgcn_permlane32_swap(a1, b1, false, false); \
    u32x4 w = {r0[0], r1[0], r0[1], r1[1]}; OUT = __builtin_bit_cast(bf16x8, w); } while (0)
    ATT_PK4(p0, 0, pa0); ATT_PK4(p0, 8, pa1); ATT_PK4(p1, 0, pa2); ATT_PK4(p1, 8, pa3);
#undef ATT_PK4
}

__device__ __forceinline__ void attn_unit(LAS unsigned char* lds, const bf16_t* __restrict__ Qh, const bf16_t* __restrict__ Kh, const bf16_t* __restrict__ Vh,
                                          int Sq, int Sk, int q0, bf16_t* __restrict__ outp, float lam, float negref, const float* __restrict__ subg) {
    const int tid = threadIdx.x, wid = __builtin_amdgcn_readfirstlane(tid >> 6), lane = tid & 63, r32 = lane & 31, hi = lane >> 5;
    const int comp = wid >> 2, qs = wid & 3;
    LAS unsigned char* V_lds = lds + V_OFF; LAS unsigned char* K_lds = lds + K_OFF;
    LAS float* wsf = (LAS float*)(lds + ATT_WSC_OFF) + wid * 64;
    bf16x8 qr[4];
    { const bf16_t* Qw = Qh + ((size_t)comp * Sq + q0 + qs * 32 + r32) * 64 + hi * 8;
#pragma unroll
      for (int d0 = 0; d0 < 4; ++d0) qr[d0] = *(const bf16x8*)(Qw + d0 * 16); }
    const int krow = tid >> 3, kcb = (tid & 7) * 16, kst = ATT_KSWZ(krow, kcb);
    const int sr = tid >> 4, sc = (tid & 15) * 8, vst0 = v_st(sr, sc), vst1 = v_st(32 + sr, sc);
    const bf16_t* Kg0 = Kh + tid * 8; const bf16_t* Kg1 = Kh + (size_t)Sk * 64 + tid * 8;
    const bf16_t* Vg0 = Vh + (size_t)sr * 128 + sc; const bf16_t* Vg1 = Vh + (size_t)(32 + sr) * 128 + sc;
    const int vb0 = (int)(unsigned)(uintptr_t)V_lds + v_rd_base(lane);
    const LAS unsigned char* Kc = K_lds + comp * 8192;
    bf16x8 sE_k0, sE_k1, sE_v0, sE_v1;
#define ATT_SLOAD(S, j) do { S##_k0 = *(const bf16x8*)(Kg0 + (size_t)(j) * 4096); S##_k1 = *(const bf16x8*)(Kg1 + (size_t)(j) * 4096); \
    S##_v0 = *(const bf16x8*)(Vg0 + (size_t)(j) * 8192); S##_v1 = *(const bf16x8*)(Vg1 + (size_t)(j) * 8192); } while (0)
#define ATT_SWRITE(b, S) do { *(LAS bf16x8*)(V_lds + (b) * 16384 + vst0) = S##_v0; *(LAS bf16x8*)(V_lds + (b) * 16384 + vst1) = S##_v1; \
    *(LAS bf16x8*)(K_lds + (b) * 16384 + kst) = S##_k0; *(LAS bf16x8*)(K_lds + (b) * 16384 + 8192 + kst) = S##_k1; } while (0)
#define ATT_SWAIT() asm volatile("s_waitcnt vmcnt(0)" ::: "memory")
    float l_reg = 0.f; f32x16 o[4];
#pragma unroll
    for (int d = 0; d < 4; ++d)
#pragma unroll
        for (int r = 0; r < 16; ++r) o[d][r] = 0.f;
    f32x16 pA0, pA1, pB0, pB1; bf16x8 pa0, pa1, pa2, pa3; const int NT = Sk / 64;
    ATT_SLOAD(sE, 0); asm volatile("s_waitcnt vmcnt(0)" ::: "memory"); ATT_SWRITE(0, sE); __syncthreads();
    qkt(pA0, pA1, Kc, qr, negref, r32, hi); exp_half(pA0);
    ATT_SLOAD(sE, 1);
    ATT_SWAIT(); ATT_SWRITE(1, sE); __syncthreads();
    for (int j = 1; j + 1 < NT; j += 2) {
        ATT_SBAR(); qkt(pB0, pB1, Kc + 16384, qr, negref, r32, hi);
        finish_sm(pA0, pA1, l_reg, pa0, pa1, pa2, pa3); ATT_SBAR();
        ATT_SLOAD(sE, j + 1); ATT_SBAR();
        pv_all(o, vb0, pa0, pa1, pa2, pa3); exp_half(pB0);
        __syncthreads(); ATT_SWAIT(); ATT_SWRITE(0, sE);
        __syncthreads();
        ATT_SBAR(); qkt(pA0, pA1, Kc, qr, negref, r32, hi);
        finish_sm(pB0, pB1, l_reg, pa0, pa1, pa2, pa3); ATT_SBAR();
        ATT_SLOAD(sE, j + 2); ATT_SBAR();
        pv_all(o, vb0 + 16384, pa0, pa1, pa2, pa3); exp_half(pA0);
        __syncthreads(); ATT_SWAIT(); ATT_SWRITE(1, sE);
        __syncthreads();
    }
    ATT_SBAR(); qkt(pB0, pB1, Kc + 16384, qr, negref, r32, hi);
    finish_sm(pA0, pA1, l_reg, pa0, pa1, pa2, pa3); ATT_SBAR();
    pv_all(o, vb0, pa0, pa1, pa2, pa3); exp_half(pB0);
    finish_sm(pB0, pB1, l_reg, pa0, pa1, pa2, pa3); ATT_SBAR();
    pv_all(o, vb0 + 16384, pa0, pa1, pa2, pa3);
#undef ATT_SLOAD
#undef ATT_SWRITE
#undef ATT_SWAIT
    { auto rr = __builtin_amdgcn_permlane32_swap(__float_as_uint(l_reg), __float_as_uint(l_reg), false, false); l_reg = __uint_as_float(rr[0]) + __uint_as_float(rr[1]); }
    int lz = lane; asm volatile("" : "+v"(lz));
    const int r32e = lz & 31, hie = lz >> 5;
    if (hie == 0) wsf[r32e] = l_reg;
    LDS_WAIT();
    float rli[16];
#pragma unroll
    for (int r = 0; r < 16; ++r) rli[r] = 1.0f / wsf[(r & 3) + 8 * (r >> 2) + 4 * hie];
    LAS float* ex = (LAS float*)(lds + EX_OFF) + qs * 4096;
    LAS float* exl = ex + lz;
    if (comp == 1) {
#pragma unroll
        for (int d0 = 0; d0 < 4; ++d0)
#pragma unroll
            for (int r = 0; r < 16; ++r) exl[(d0 * 16 + r) * 64] = o[d0][r] * rli[r];
    }
    __syncthreads();
    if (comp == 0) {
#pragma unroll
        for (int d0 = 0; d0 < 4; ++d0)
#pragma unroll
            for (int r = 0; r < 16; ++r) o[d0][r] = o[d0][r] * rli[r] - lam * exl[(d0 * 16 + r) * 64];
        LDS_WAIT(); asm volatile("" ::: "memory");
        LAS float* wb[4];
#pragma unroll
        for (int q = 0; q < 4; ++q) { const int rq = q + 4 * hie; wb[q] = ex + rq * 128 + (r32e ^ (rq << 2)); }
#pragma unroll
        for (int d0 = 0; d0 < 4; ++d0)
#pragma unroll
            for (int r = 0; r < 16; ++r) wb[r & 3][(r >> 2) * 1024 + d0 * 32] = o[d0][r];
        LDS_WAIT(); asm volatile("" ::: "memory");
        const int row2 = lz >> 1, half = lz & 1, x3 = (row2 & 7) << 2;
        const LAS float* rb = ex + row2 * 128 + 64 * half;
        f32x4 v[16]; float ss = 0.f;
#pragma unroll
        for (int i = 0; i < 16; ++i) { v[i] = *(const LAS f32x4*)(rb + ((4 * i) ^ x3)); ss += (v[i][0] * v[i][0] + v[i][1] * v[i][1]) + (v[i][2] * v[i][2] + v[i][3] * v[i][3]); }
        ss += __shfl_xor(ss, 1);
        const float rinv = rsqrtf(ss * (1.0f / 128.0f) + EPS) * ONE_M_LAMINIT;
        bf16_t* orow = outp + (size_t)(q0 + qs * 32 + row2) * KOUT + 64 * half;
        const float* sg = subg + 64 * half;
#pragma unroll
        for (int i = 0; i < 8; ++i) { const f32x4 g0 = *(const f32x4*)(sg + 8 * i), g1 = *(const f32x4*)(sg + 8 * i + 4); const f32x4 a = v[2 * i] * rinv * g0, b = v[2 * i + 1] * rinv * g1;
            u32x4 w; w.x = pk2(a[0], a[1]); w.y = pk2(a[2], a[3]); w.z = pk2(b[0], b[1]); w.w = pk2(b[2], b[3]); *(u32x4*)(orow + 8 * i) = w; }
    }
}
#undef ATT_KSWZ
#undef ATT_SBAR
}
struct Params {
    const float *x_p, *x_s, *cache_k, *cache_v, *c, *c_ctx, *n1, *n2, *w_ada, *b_ada, *w_in, *qg, *kg, *lq1, *lk1, *lq2, *lk2, *subg, *w_out, *w_gate, *w_up, *conv_w, *conv_b, *w_down;
    float* out; unsigned char* ws; int ph_lo, ph_hi, li, pad;
};
__device__ __forceinline__ int invperm32(int c) { return 16 * ((c >> 2) & 1) + 4 * (c >> 3) + (c & 3); }
__device__ __forceinline__ int rowperm(int n) { return (n & ~31) | invperm32(n & 31); }
__device__ __forceinline__ const float* xrow_ptr(const Params& P, int m) { return m < NTOK_P ? P.x_p + (size_t)m * DM : P.x_s + (size_t)(m - NTOK_P) * DM; }
__device__ __forceinline__ int modrow_of_tile(int pm) { return pm < 16 ? 0 : 1 + ((pm - 16) >> 2); }

template <int NC> __device__ __forceinline__ void gemv9_slab(const LAS float* vec, LAS float* red, const float* __restrict__ W, int ldw, int c0, const float* __restrict__ bias, float* __restrict__ out, int ldo, int oc0, int tid) {
    constexpr int NCG = NC / 4, KPAR = 512 / NCG, KP = KPAR + 1;
    const int cg = tid % NCG, ks = tid / NCG;
    float a[9][4];
#pragma unroll
    for (int j = 0; j < 9; ++j)
#pragma unroll
        for (int e = 0; e < 4; ++e) a[j][e] = 0.f;
    if (ks < KPAR) {
        constexpr int NI = (1024 + KPAR - 1) / KPAR;
        f32x4 w[NI];
#pragma unroll
        for (int i = 0; i < NI; ++i) { const int k = ks + i * KPAR; w[i] = (k < 1024) ? *(const f32x4*)(W + (size_t)k * ldw + c0 + 4 * cg) : (f32x4){0.f, 0.f, 0.f, 0.f}; }
#pragma unroll
        for (int i = 0; i < NI; ++i) { const int k = ks + i * KPAR; const int kc = k < 1024 ? k : 1023;
#pragma unroll
            for (int j = 0; j < 9; ++j) { const float v = vec[j * 1024 + kc]; a[j][0] += v * w[i][0]; a[j][1] += v * w[i][1]; a[j][2] += v * w[i][2]; a[j][3] += v * w[i][3]; }
        }
#pragma unroll
        for (int j = 0; j < 9; ++j)
#pragma unroll
            for (int e = 0; e < 4; ++e) red[(j * NC + cg * 4 + e) * KP + ks] = a[j][e];
    }
    __syncthreads();
    if (tid < 9 * NC) { float s = 0.f; for (int q = 0; q < KPAR; ++q) s += red[tid * KP + q]; const int j = tid / NC, c = tid % NC; out[(size_t)j * ldo + oc0 + c] = s + (bias ? bias[oc0 + c] : 0.f); }
    __syncthreads();
}
template <class DestRow>
__device__ __forceinline__ void transpose_item(const float* __restrict__ W, int ldw, int k0, int n0, bf16_t* __restrict__ WT, int ldt, int kd0, DestRow dest, LAS float* scr, int lane) {
    float tv[32];
#pragma unroll
    for (int i = 0; i < 32; ++i) tv[i] = W[(size_t)(k0 + 2 * i + (lane >> 5)) * ldw + n0 + (lane & 31)];
#pragma unroll
    for (int i = 0; i < 32; ++i) scr[(2 * i + (lane >> 5)) * 33 + (lane & 31)] = tv[i];
    LDS_WAIT(); asm volatile("" ::: "memory");
    const int c = lane & 7;
#pragma unroll
    for (int j = 0; j < 4; ++j) { const int n = (lane >> 3) + 8 * j; const LAS float* s = scr + (8 * c) * 33 + n;
        u32x4 o; o.x = pk2(s[0 * 33], s[1 * 33]); o.y = pk2(s[2 * 33], s[3 * 33]); o.z = pk2(s[4 * 33], s[5 * 33]); o.w = pk2(s[6 * 33], s[7 * 33]);
        *(u32x4*)(WT + (size_t)dest(n0 + n) * ldt + kd0 + 8 * c) = o; }
    LDS_WAIT(); asm volatile("" ::: "memory");
}
struct DestIn { __device__ __forceinline__ int operator()(int n) const { const int tile = n >> 8, tc = n & 255; int p;
    if (tile == 0) p = tc; else if (tile <= 6) p = 128 * ((tc >> 5) & 1) + 32 * (tc >> 6) + (tc & 31); else p = rowperm(tc); return tile * 256 + p; } };
struct DestPerm { __device__ __forceinline__ int operator()(int n) const { return rowperm(n); } };
struct DestGU { int up; __device__ __forceinline__ int operator()(int f) const { return (f >> 7) * 256 + up * 128 + rowperm(f & 127); } };
__device__ __forceinline__ void fout_item(const float* __restrict__ w_out, bf16_t* __restrict__ WT, int h, int nb, LAS float* scr, int lane) {
#pragma unroll
    for (int i = 0; i < 16; ++i) { const int d = 4 * i + (lane >> 4), j = lane & 15; scr[d * 17 + j] = w_out[(size_t)(64 * h + d) * DM + 16 * nb + j]; }
    LAS float* ctab = scr + 1088; LAS float* stab = scr + 1152;
    ctab[lane] = __builtin_amdgcn_cosf((float)lane * (1.0f / 64.0f)); stab[lane] = __builtin_amdgcn_sinf((float)lane * (1.0f / 64.0f));
    LDS_WAIT(); asm volatile("" ::: "memory");
    float ac[16], as_[16];
#pragma unroll
    for (int j = 0; j < 16; ++j) { ac[j] = 0.f; as_[j] = 0.f; }
#pragma unroll 2
    for (int d = 0; d < 64; ++d) { const int idx = (d * lane) & 63; const float cv = ctab[idx], sv = stab[idx];
#pragma unroll
        for (int j = 0; j < 16; ++j) { const float w = scr[d * 17 + j]; ac[j] += cv * w; as_[j] += sv * w; } }
#pragma unroll
    for (int j = 0; j < 16; ++j) { const int row = rowperm(16 * nb + j);
        WT[(size_t)row * KOUT + 64 * h + lane] = f2bf(ac[j] * 0.125f); WT[(size_t)row * KOUT + 256 + 64 * h + lane] = f2bf(-as_[j] * 0.125f); }
    LDS_WAIT(); asm volatile("" ::: "memory");
}

constexpr int I_TIN = 16 * 80, I_TOUT = 12 * 32, I_TG = 16 * 88, I_TU = 16 * 88, I_TDN = 44 * 32, I_FOUT = 4 * 64, I_CK = 768, I_CV = 768, I_DFTS = 4096, I_DFTP = 256, I_ROPE = 1;
constexpr int P0_ITEMS = I_TIN + I_TOUT + I_FOUT + I_CK + I_CV + I_DFTS + I_DFTP + I_ROPE;
constexpr int FFNW_ITEMS = I_TG + I_TU + I_TDN;
__device__ __forceinline__ void ffn_weight_items(const Params& P, LAS unsigned char* lds, int lane, int wave, int first, int stride) {
    LAS float* scr = (LAS float*)(lds + wave * 9216);
    bf16_t* Wt_gu = (bf16_t*)(P.ws + WS_WGU); bf16_t* Wt_dn = (bf16_t*)(P.ws + WS_WDN);
    for (int it = first; it < FFNW_ITEMS; it += stride) {
        int r = it;
        if (r < I_TG) { transpose_item(P.w_gate, DFF, 64 * (r / 88), 32 * (r % 88), Wt_gu, DM, 64 * (r / 88), DestGU{0}, scr, lane); continue; } r -= I_TG;
        if (r < I_TU) { transpose_item(P.w_up, DFF, 64 * (r / 88), 32 * (r % 88), Wt_gu, DM, 64 * (r / 88), DestGU{1}, scr, lane); continue; } r -= I_TU;
        { const int kb = r >> 5, nb = r & 31; transpose_item(P.w_down, DM, 64 * kb, 32 * nb, Wt_dn, DFF, 64 * kb, DestPerm{}, scr, lane); }
    }
}
__device__ __forceinline__ void p0_prep(const Params& P, LAS unsigned char* lds, int tid, int lane, int wave, int vcu, int G) {
    unsigned char* ws = P.ws;
    LAS float* vec = (LAS float*)lds; LAS float* red = (LAS float*)(lds + 36864);
    for (int i = tid; i < 9 * 1024; i += 512) { const int j = i >> 10, k = i & 1023; const float x = (j == 0) ? P.c_ctx[k] : P.c[(j - 1) * 1024 + k]; vec[i] = x / (1.0f + expf(-x)); }
    __syncthreads();
    for (int s = blockIdx.x; s < NADA / 24; s += G) gemv9_slab<24>(vec, red, P.w_ada, NADA, 24 * s, P.b_ada, (float*)(ws + WS_ADA), NADA, 24 * s, tid);
    __syncthreads();
    LAS float* scr = (LAS float*)(lds + wave * 9216);
    bf16_t* Wt_in = (bf16_t*)(ws + WS_WIN); bf16_t* Wt_out = (bf16_t*)(ws + WS_WOUT); bf16_t* Wt_gu = (bf16_t*)(ws + WS_WGU); bf16_t* Wt_dn = (bf16_t*)(ws + WS_WDN);
    const int gw = vcu * NWAVES + wave, NGW = G * NWAVES;
    for (int it = gw; it < P0_ITEMS; it += NGW) {
        int r = it;
        if (r < I_TIN) { transpose_item(P.w_in, DIN, 64 * (r / 80), 32 * (r % 80), Wt_in, DM, 64 * (r / 80), DestIn{}, scr, lane); continue; } r -= I_TIN;
        if (r < I_TOUT) { const int kb = r >> 5, nb = r & 31; transpose_item(P.w_out, DM, 256 + 64 * kb, 32 * nb, Wt_out, KOUT, 512 + 64 * kb, DestPerm{}, scr, lane); continue; } r -= I_TOUT;
        if (r < I_FOUT) { fout_item(P.w_out, Wt_out, r >> 6, r & 63, scr, lane); continue; } r -= I_FOUT;
        if (r < I_CK) {
            bf16_t* Ks = (bf16_t*)(ws + WS_K_S); float mx = 0.f;
            f32x4 xv[16];
#pragma unroll
            for (int j = 0; j < 16; ++j) xv[j] = *(const f32x4*)(P.cache_k + (size_t)(r * 1024 + j * 64 + lane) * 4);
#pragma unroll
            for (int j = 0; j < 16; ++j) { const int q4 = r * 1024 + j * 64 + lane, e = q4 * 4; const f32x4 x = xv[j];
                const int d = e & 63, cc = (e >> 6) & 1, p = (e >> 7) & 511, bh = e >> 16;
                u32x2 w; w.x = pk2(x[0], x[1]); w.y = pk2(x[2], x[3]); *(u32x2*)(Ks + ((size_t)(bh * 2 + cc) * SKS + 1024 + p) * 64 + d) = w;
                float ss = (x[0] * x[0] + x[1] * x[1]) + (x[2] * x[2] + x[3] * x[3]);
                ss += __shfl_xor(ss, 1); ss += __shfl_xor(ss, 2); ss += __shfl_xor(ss, 4); ss += __shfl_xor(ss, 8); mx = fmaxf(mx, ss); }
            mx = wave_max(mx);
            if (lane == 0) atomicMax((unsigned*)(ws + WS_CTL) + CW_KMAX, __float_as_uint(mx));
            continue; } r -= I_CK;
        if (r < I_CV) {
            bf16_t* Vs = (bf16_t*)(ws + WS_V_S);
            f32x4 xv[16];
#pragma unroll
            for (int j = 0; j < 16; ++j) xv[j] = *(const f32x4*)(P.cache_v + (size_t)(r * 1024 + j * 64 + lane) * 4);
#pragma unroll
            for (int j = 0; j < 16; ++j) { const int q4 = r * 1024 + j * 64 + lane, e = q4 * 4; const f32x4 x = xv[j];
                const int dv = e & 127, p = (e >> 7) & 511, bh = e >> 16;
                u32x2 w; w.x = pk2(x[0], x[1]); w.y = pk2(x[2], x[3]); *(u32x2*)(Vs + ((size_t)bh * SKS + 1024 + p) * 128 + dv) = w; }
            continue; } r -= I_CV;
        if (r < I_DFTS + I_DFTP) {
            const bool smp = r < I_DFTS; const int lg = smp ? 10 : 8, S = 1 << lg; const int item = smp ? r : r - I_DFTS; bf16_t* Dm = (bf16_t*)(ws + (smp ? WS_DFTS : WS_DFTP));
            const float sc = smp ? 0.03125f : 0.0625f, invS = 1.0f / (float)S; const int idx0 = item * 512 + lane * 8, f = idx0 >> lg, s0 = idx0 & (S - 1), kf = f & (S - 1); const bool isSin = f >= S;
            float v[8];
#pragma unroll
            for (int i = 0; i < 8; ++i) { const float fr = (float)((kf * (s0 + i)) & (S - 1)) * invS; v[i] = (isSin ? __builtin_amdgcn_sinf(fr) : __builtin_amdgcn_cosf(fr)) * sc; }
            u32x4 w; w.x = pk2(v[0], v[1]); w.y = pk2(v[2], v[3]); w.z = pk2(v[4], v[5]); w.w = pk2(v[6], v[7]); *(u32x4*)(Dm + idx0) = w;
            continue; } r -= I_DFTS + I_DFTP;
        {
            f32x2* T = (f32x2*)(ws + WS_ROPE);
#pragma unroll
            for (int j = 0; j < 16; ++j) { const int ent = j * 64 + lane, pos = ent >> 4, i = ent & 15; const float inv = powf(10000.0f, -(float)i * (1.0f / 16.0f)); const float ang = (float)pos * inv, rev = ang * 0.15915494309189535f;
                T[ent] = (f32x2){__builtin_amdgcn_cosf(rev), __builtin_amdgcn_sinf(rev)}; }
        }
    }
}

__device__ __forceinline__ void p1_norm(const Params& P, LAS unsigned char* lds, int tid, int lane, int wave, int vcu, int G) {
    unsigned char* ws = P.ws; const float* ada = (const float*)(ws + WS_ADA);
    LAS float* vec = (LAS float*)lds; LAS float* red = (LAS float*)(lds + 36864);
    for (int i = tid; i < 9 * 1024; i += 512) { const int j = i >> 10, k = i & 1023; vec[i] = ada[(size_t)j * NADA + 3072 + k]; }
    __syncthreads();
    for (int s = blockIdx.x; s < 352; s += G) { const int mat = s / 176, c0 = (s % 176) * 16;
        gemv9_slab<16>(vec, red, mat ? P.w_up : P.w_gate, DFF, c0, nullptr, (float*)(ws + WS_BIAS2), NGU, mat * DFF + c0, tid); }
    bf16_t* Hb = (bf16_t*)(ws + WS_H);
    const int gw = vcu * NWAVES + wave, NGW = G * NWAVES;
    f32x4 g1v[4];
#pragma unroll
    for (int j = 0; j < 4; ++j) g1v[j] = ((const f32x4*)P.n1)[lane + 64 * j];
    f32x4 xv[4], shv[4], scv[4];
#define P1_LOAD(m_) do { const int mr_ = (m_) < NTOK_P ? 0 : 1 + (((m_) - NTOK_P) >> 10); const f32x4* xr_ = (const f32x4*)xrow_ptr(P, (m_)) + lane; \
        const f32x4* sh_ = (const f32x4*)(ada + (size_t)mr_ * NADA) + lane; const f32x4* sc_ = (const f32x4*)(ada + (size_t)mr_ * NADA + 1024) + lane; \
        _Pragma("unroll") for (int j = 0; j < 4; ++j) { xv[j] = xr_[64 * j]; shv[j] = sh_[64 * j]; scv[j] = sc_[64 * j]; } } while (0)
    if (gw < NTOK) P1_LOAD(gw);
    for (int m = gw; m < NTOK; m += NGW) {
        f32x4 v[4], shc[4], scc[4];
#pragma unroll
        for (int j = 0; j < 4; ++j) { v[j] = xv[j]; shc[j] = shv[j]; scc[j] = scv[j]; }
        if (m + NGW < NTOK) P1_LOAD(m + NGW);
        float s = 0.f;
#pragma unroll
        for (int j = 0; j < 4; ++j) s += (v[j][0] * v[j][0] + v[j][1] * v[j][1]) + (v[j][2] * v[j][2] + v[j][3] * v[j][3]);
        const float rstd = rsqrtf(wave_sum(s) * (1.0f / DM) + EPS);
        u32x2* o8 = (u32x2*)(Hb + (size_t)m * DM) + lane;
#pragma unroll
        for (int j = 0; j < 4; ++j) { const f32x4 hv = v[j] * rstd * g1v[j] * (scc[j] + 1.0f) + shc[j]; u32x2 w; w.x = pk2(hv[0], hv[1]); w.y = pk2(hv[2], hv[3]); o8[64 * j] = w; }
    }
#undef P1_LOAD
}

using pg8::Unit;
struct EpiInProj {
    static constexpr bool PERM = false, AFTER_DRAIN = false;
    unsigned char* ws; float* newk; float* newv; const float* qg; const float* kg;
    __device__ __forceinline__ void operator()(const f32x4 (&acc)[2][2][4][2], const Unit& u, int wr, int wc, int fr_, int fq_) const {
        int fr = fr_, fq = fq_; asm volatile("" : "+v"(fr), "+v"(fq));
        const bool prompt = u.pm < 16; const int b = prompt ? u.pm : (u.pm - 16) >> 2; const int s0 = prompt ? 0 : ((u.pm - 16) & 3) * 256; const int S = prompt ? SP : SS, Sk = prompt ? SP : SKS;
        if (u.pn == 0) {
            bf16_t* base = (bf16_t*)(ws + (prompt ? WS_XFT_P : WS_XFT_S)) + (size_t)b * 256 * S;
#pragma unroll
            for (int ai = 0; ai < 2; ++ai)
#pragma unroll
                for (int m = 0; m < 4; ++m) { const int s = s0 + 128 * ai + 64 * wr + 16 * m + fr;
#pragma unroll
                    for (int bj = 0; bj < 2; ++bj)
#pragma unroll
                        for (int n = 0; n < 2; ++n)
#pragma unroll
                            for (int e = 0; e < 4; ++e) { const int ch = 128 * bj + 32 * wc + 16 * n + 4 * fq + e; base[(size_t)ch * S + s] = f2bf(acc[ai][bj][m][n][e]); } }
        } else if (u.pn <= 6) {
            const bool isq = u.pn <= 3; const int t = isq ? u.pn - 1 : u.pn - 4; const int head = 2 * t + (wc >> 1), comp = wc & 1;
            const float* gsrc = isq ? qg : kg; f32x4 g[2][2];
#pragma unroll
            for (int bj = 0; bj < 2; ++bj)
#pragma unroll
                for (int n = 0; n < 2; ++n) g[bj][n] = *(const f32x4*)(gsrc + 32 * bj + 16 * n + 4 * fq);
            bf16_t* dst = isq ? (bf16_t*)(ws + (prompt ? WS_Q_P : WS_Q_S)) + ((size_t)((b * NH + head) * 2 + comp) * S) * 64
                              : (bf16_t*)(ws + (prompt ? WS_K_P : WS_K_S)) + ((size_t)((b * NH + head) * 2 + comp) * Sk) * 64;
            const f32x2* rope = (const f32x2*)(ws + WS_ROPE);
#pragma unroll
            for (int ai = 0; ai < 2; ++ai) {
#pragma unroll
                for (int m = 0; m < 4; ++m) { const int s = s0 + 128 * ai + 64 * wr + 16 * m + fr;
                    f32x4 rt[2][2];
#pragma unroll
                    for (int bj = 0; bj < 2; ++bj) { const int pos = bj == 0 ? (s >> 6) : (s & 63); const f32x4* tp = (const f32x4*)(rope + pos * 16 + 4 * fq); rt[bj][0] = tp[0]; rt[bj][1] = tp[1]; }
                    f32x4 v[2][2]; float ss = 0.f;
#pragma unroll
                    for (int bj = 0; bj < 2; ++bj)
#pragma unroll
                        for (int n = 0; n < 2; ++n) { v[bj][n] = acc[ai][bj][m][n]; ss += (v[bj][n][0] * v[bj][n][0] + v[bj][n][1] * v[bj][n][1]) + (v[bj][n][2] * v[bj][n][2] + v[bj][n][3] * v[bj][n][3]); }
                    ss += __shfl_xor(ss, 16); ss += __shfl_xor(ss, 32);
                    const float rinv = rsqrtf(ss * (1.0f / 64.0f) + EPS);
#pragma unroll
                    for (int bj = 0; bj < 2; ++bj)
#pragma unroll
                        for (int n = 0; n < 2; ++n) v[bj][n] = v[bj][n] * rinv * g[bj][n];
                    if (!prompt) {
#pragma unroll
                        for (int bj = 0; bj < 2; ++bj) { const f32x4 t0 = rt[bj][0], t1 = rt[bj][1];
                            const float cs[4] = {t0[0], t0[2], t1[0], t1[2]}, sn[4] = {t0[1], t0[3], t1[1], t1[3]};
#pragma unroll
                            for (int e = 0; e < 4; ++e) { const float x1 = v[bj][0][e], x2 = v[bj][1][e]; v[bj][0][e] = x1 * cs[e] - x2 * sn[e]; v[bj][1][e] = x2 * cs[e] + x1 * sn[e]; } }
                    }
                    if (!isq && prompt) { float* nk = newk + ((size_t)((b * NH + head) * SP + s) * 2 + comp) * 64 + 4 * fq;
#pragma unroll
                        for (int bj = 0; bj < 2; ++bj)
#pragma unroll
                            for (int n = 0; n < 2; ++n) *(f32x4*)(nk + 32 * bj + 16 * n) = v[bj][n]; }
                    const float osc = isq ? C2 : 1.0f; bf16_t* drow = dst + (size_t)s * 64 + 4 * fq;
#pragma unroll
                    for (int bj = 0; bj < 2; ++bj)
#pragma unroll
                        for (int n = 0; n < 2; ++n) { const f32x4 x = v[bj][n] * osc; u32x2 w; w.x = pk2(x[0], x[1]); w.y = pk2(x[2], x[3]); *(u32x2*)(drow + 32 * bj + 16 * n) = w; }
                    asm volatile("" ::: "memory");
                }
            }
        } else {
            const int t = u.pn - 7;
#pragma unroll
            for (int bj = 0; bj < 2; ++bj) { const int head = 2 * t + bj;
                bf16_t* dst = (bf16_t*)(ws + (prompt ? WS_V_P : WS_V_S)) + ((size_t)(b * NH + head) * Sk) * 128 + 32 * wc + 8 * fq;
                float* nv = newv + ((size_t)(b * NH + head) * SP) * 128 + 32 * wc + 8 * fq;
#pragma unroll
                for (int ai = 0; ai < 2; ++ai)
#pragma unroll
                    for (int m = 0; m < 4; ++m) { const int s = s0 + 128 * ai + 64 * wr + 16 * m + fr; const f32x4 a = acc[ai][bj][m][0], c = acc[ai][bj][m][1];
                        u32x4 w; w.x = pk2(a[0], a[1]); w.y = pk2(a[2], a[3]); w.z = pk2(c[0], c[1]); w.w = pk2(c[2], c[3]); *(u32x4*)(dst + (size_t)s * 128) = w;
                        if (prompt) { *(f32x4*)(nv + (size_t)s * 128) = a; *(f32x4*)(nv + (size_t)s * 128 + 4) = c; } } }
        }
    }
};
struct EpiFourier {
    static constexpr bool PERM = false, AFTER_DRAIN = false;
    bf16_t* mix; int S, tok0;
    __device__ __forceinline__ void operator()(const f32x4 (&acc)[2][2][4][2], const Unit& u, int wr, int wc, int fr_, int fq_) const {
        int fr = fr_, fq = fq_; asm volatile("" : "+v"(fr), "+v"(fq));
        const int f0 = u.pm * 256, part = f0 >= S ? 1 : 0; const int k0 = f0 - part * S;
#pragma unroll
        for (int ai = 0; ai < 2; ++ai)
#pragma unroll
            for (int m = 0; m < 4; ++m) { bf16_t* rowp = mix + (size_t)(tok0 + u.pn * S + k0 + 128 * ai + 64 * wr + 16 * m + fr) * KOUT + part * 256 + 32 * wc + 4 * fq;
#pragma unroll
                for (int bj = 0; bj < 2; ++bj)
#pragma unroll
                    for (int n = 0; n < 2; ++n) { const f32x4 x = acc[ai][bj][m][n]; u32x2 w; w.x = pk2(x[0], x[1]); w.y = pk2(x[2], x[3]); *(u32x2*)(rowp + 128 * bj + 16 * n) = w; } }
    }
};
struct EpiOut {
    static constexpr bool PERM = false, AFTER_DRAIN = false;
    Params P;
    __device__ __forceinline__ void operator()(const f32x4 (&acc)[2][2][4][2], const Unit& u, int wr, int wc, int fr_, int fq_) const {
        int fr = fr_, fq = fq_; asm volatile("" : "+v"(fr), "+v"(fq));
        const float* ada = (const float*)(P.ws + WS_ADA) + (size_t)modrow_of_tile(u.pm) * NADA; bf16_t* x1s = (bf16_t*)(P.ws + WS_H); float* ssq = (float*)(P.ws + WS_SSQ);
        const int c0 = u.pn * 256 + 32 * wc + 8 * fq;
        f32x4 g1[2][2], md[2][2];
#pragma unroll
        for (int bj = 0; bj < 2; ++bj)
#pragma unroll
            for (int n = 0; n < 2; ++n) { const int c = c0 + 128 * bj + 4 * n; g1[bj][n] = *(const f32x4*)(ada + 2048 + c); md[bj][n] = *(const f32x4*)(P.n2 + c) * (*(const f32x4*)(ada + 4096 + c) + 1.0f); }
#pragma unroll
        for (int am = 0; am < 4; ++am) { const int ai = am >> 1;
            f32x4 xv[4][2][2];
#pragma unroll
            for (int m = 2 * (am & 1); m < 2 * (am & 1) + 2; ++m) { const int r = u.pm * 256 + 128 * ai + 64 * wr + 16 * m + fr; const float* xr = xrow_ptr(P, r) + c0;
#pragma unroll
                for (int bj = 0; bj < 2; ++bj) { xv[m][bj][0] = *(const f32x4*)(xr + 128 * bj); xv[m][bj][1] = *(const f32x4*)(xr + 128 * bj + 4); } }
#pragma unroll
            for (int m = 2 * (am & 1); m < 2 * (am & 1) + 2; ++m) { const int r = u.pm * 256 + 128 * ai + 64 * wr + 16 * m + fr; float* yr = (float*)(P.ws + WS_X1) + (size_t)r * DM + c0; bf16_t* hr = x1s + (size_t)r * DM + c0;
                float ss = 0.f;
#pragma unroll
                for (int bj = 0; bj < 2; ++bj) {
                    const f32x4 ya = xv[m][bj][0] + g1[bj][0] * acc[ai][bj][m][0], yb = xv[m][bj][1] + g1[bj][1] * acc[ai][bj][m][1];
                    *(f32x4*)(yr + 128 * bj) = ya; *(f32x4*)(yr + 128 * bj + 4) = yb;
                    ss += (ya[0] * ya[0] + ya[1] * ya[1]) + (ya[2] * ya[2] + ya[3] * ya[3]) + (yb[0] * yb[0] + yb[1] * yb[1]) + (yb[2] * yb[2] + yb[3] * yb[3]);
                    const f32x4 ha = ya * md[bj][0], hb = yb * md[bj][1]; u32x4 w; w.x = pk2(ha[0], ha[1]); w.y = pk2(ha[2], ha[3]); w.z = pk2(hb[0], hb[1]); w.w = pk2(hb[2], hb[3]); *(u32x4*)(hr + 128 * bj) = w; }
                ss += __shfl_xor(ss, 16); ss += __shfl_xor(ss, 32);
                if (fq == 0) ssq[(size_t)r * 16 + u.pn * 4 + wc] = ss; }
        }
    }
};
struct EpiGU {
    static constexpr bool PERM = false, AFTER_DRAIN = false;
    unsigned char* ws;
    __device__ __forceinline__ void operator()(const f32x4 (&acc)[2][2][4][2], const Unit& u, int wr, int wc, int fr_, int fq_) const {
        int fr = fr_, fq = fq_; asm volatile("" : "+v"(fr), "+v"(fq));
        const float* b2 = (const float*)(ws + WS_BIAS2) + (size_t)modrow_of_tile(u.pm) * NGU; const float* ssq = (const float*)(ws + WS_SSQ);
        bf16_t* Gb = (bf16_t*)(ws + WS_G); bf16_t* Ub = (bf16_t*)(ws + WS_U);
        const int f0 = u.pn * 128 + 32 * wc + 8 * fq;
        const f32x4 bg0 = *(const f32x4*)(b2 + f0), bg1 = *(const f32x4*)(b2 + f0 + 4), bu0 = *(const f32x4*)(b2 + DFF + f0), bu1 = *(const f32x4*)(b2 + DFF + f0 + 4);
#pragma unroll
        for (int ai = 0; ai < 2; ++ai) {
            f32x4 sv[4][4];
#pragma unroll
            for (int m = 0; m < 4; ++m) { const int r = u.pm * 256 + 128 * ai + 64 * wr + 16 * m + fr; const f32x4* sp = (const f32x4*)(ssq + (size_t)r * 16);
#pragma unroll
                for (int q = 0; q < 4; ++q) sv[m][q] = sp[q]; }
#pragma unroll
            for (int m = 0; m < 4; ++m) { const int r = u.pm * 256 + 128 * ai + 64 * wr + 16 * m + fr;
                const f32x4 s0 = sv[m][0], s1 = sv[m][1], s2 = sv[m][2], s3 = sv[m][3];
                const float tot = ((s0[0] + s0[1]) + (s0[2] + s0[3])) + ((s1[0] + s1[1]) + (s1[2] + s1[3])) + ((s2[0] + s2[1]) + (s2[2] + s2[3])) + ((s3[0] + s3[1]) + (s3[2] + s3[3]));
                const float rstd = rsqrtf(tot * (1.0f / DM) + EPS);
                const f32x4 ga = acc[ai][0][m][0] * rstd + bg0, gb = acc[ai][0][m][1] * rstd + bg1, ua = acc[ai][1][m][0] * rstd + bu0, ub = acc[ai][1][m][1] * rstd + bu1;
                u32x4 w; w.x = pk2(ga[0], ga[1]); w.y = pk2(ga[2], ga[3]); w.z = pk2(gb[0], gb[1]); w.w = pk2(gb[2], gb[3]); *(u32x4*)(Gb + (size_t)r * DFF + f0) = w;
                u32x4 z; z.x = pk2(ua[0], ua[1]); z.y = pk2(ua[2], ua[3]); z.z = pk2(ub[0], ub[1]); z.w = pk2(ub[2], ub[3]); *(u32x4*)(Ub + (size_t)r * DFF + f0) = z; }
        }
    }
};
struct EpiDown {
    static constexpr bool PERM = false, AFTER_DRAIN = false;
    unsigned char* ws; float* out;
    __device__ __forceinline__ void operator()(const f32x4 (&acc)[2][2][4][2], const Unit& u, int wr, int wc, int fr_, int fq_) const {
        int fr = fr_, fq = fq_; asm volatile("" : "+v"(fr), "+v"(fq));
        const float* ada = (const float*)(ws + WS_ADA) + (size_t)modrow_of_tile(u.pm) * NADA;
        const int c0 = u.pn * 256 + 32 * wc + 8 * fq;
        f32x4 g2[2][2];
#pragma unroll
        for (int bj = 0; bj < 2; ++bj)
#pragma unroll
            for (int n = 0; n < 2; ++n) g2[bj][n] = *(const f32x4*)(ada + 5120 + c0 + 128 * bj + 4 * n);
#pragma unroll
        for (int ai = 0; ai < 2; ++ai) {
            f32x4 yv[4][2][2];
#pragma unroll
            for (int m = 0; m < 4; ++m) { const float* yr = (const float*)(ws + WS_X1) + (size_t)(u.pm * 256 + 128 * ai + 64 * wr + 16 * m + fr) * DM + c0;
#pragma unroll
                for (int bj = 0; bj < 2; ++bj)
#pragma unroll
                    for (int n = 0; n < 2; ++n) yv[m][bj][n] = *(const f32x4*)(yr + 128 * bj + 4 * n); }
#pragma unroll
            for (int m = 0; m < 4; ++m) { float* yr = out + (size_t)(u.pm * 256 + 128 * ai + 64 * wr + 16 * m + fr) * DM + c0;
#pragma unroll
                for (int bj = 0; bj < 2; ++bj)
#pragma unroll
                    for (int n = 0; n < 2; ++n) *(f32x4*)(yr + 128 * bj + 4 * n) = yv[m][bj][n] + g2[bj][n] * acc[ai][bj][m][n]; }
        }
    }
};
struct OneUnitSched {
    int has; Unit u0;
    __device__ __forceinline__ bool next(int i, Unit& u) const { if (i > 0 || !has) return false; u = u0; return true; }
    __device__ __forceinline__ void a_ready(const Unit&) const {}
    __device__ __forceinline__ void done(const Unit&) const {}
};

__device__ __forceinline__ float bf_lo(unsigned w) { return __uint_as_float(w << 16); }
__device__ __forceinline__ float bf_hi(unsigned w) { return __uint_as_float(w & 0xffff0000u); }
__device__ __forceinline__ void p6_act(const Params& P, int tid, int G) {
    const bf16_t* Gb = (const bf16_t*)(P.ws + WS_G); bf16_t* Ub = (bf16_t*)(P.ws + WS_U);
    constexpr int CG = DFF / 8, RPC = 36;
    const int gt = blockIdx.x * 512 + tid, cg = gt % CG, r0 = (gt / CG) * RPC;
    if (r0 < NTOK) {
        const int r1 = (r0 + RPC < NTOK) ? r0 + RPC : NTOK, f0 = cg * 8;
        float w0[8], w1[8], w2[8], cb[8];
        { const f32x4 a0 = *(const f32x4*)(P.conv_w + f0), a1 = *(const f32x4*)(P.conv_w + f0 + 4), b0 = *(const f32x4*)(P.conv_w + DFF + f0), b1 = *(const f32x4*)(P.conv_w + DFF + f0 + 4);
          const f32x4 c0 = *(const f32x4*)(P.conv_w + 2 * DFF + f0), c1 = *(const f32x4*)(P.conv_w + 2 * DFF + f0 + 4), d0 = *(const f32x4*)(P.conv_b + f0), d1 = *(const f32x4*)(P.conv_b + f0 + 4);
#pragma unroll
          for (int i = 0; i < 4; ++i) { w0[i] = a0[i]; w0[4 + i] = a1[i]; w1[i] = b0[i]; w1[4 + i] = b1[i]; w2[i] = c0[i]; w2[4 + i] = c1[i]; cb[i] = d0[i]; cb[4 + i] = d1[i]; } }
        const u32x4 zero = {0u, 0u, 0u, 0u};
        u32x4 gp = r0 > 0 ? *(const u32x4*)(Gb + (size_t)(r0 - 1) * DFF + f0) : zero;
        u32x4 gc = *(const u32x4*)(Gb + (size_t)r0 * DFF + f0);
        for (int r = r0; r < r1; r += 4) {
            u32x4 gn[4], uu[4];
#pragma unroll
            for (int i = 0; i < 4; ++i) { const int rn = (r + 1 + i < NTOK) ? r + 1 + i : NTOK - 1; gn[i] = *(const u32x4*)(Gb + (size_t)rn * DFF + f0); uu[i] = *(const u32x4*)(Ub + (size_t)(r + i) * DFF + f0); }
#pragma unroll
            for (int i = 0; i < 4; ++i) { const int rr = r + i; const int sl = rr < NTOK_P ? (rr & 255) : ((rr - NTOK_P) & 1023); const int last = rr < NTOK_P ? 255 : 1023;
                const u32x4 gl = sl > 0 ? gp : zero, gr = sl < last ? gn[i] : zero;
                float res[8];
#pragma unroll
                for (int q = 0; q < 4; ++q) {
                    const float xl = bf_lo(gl[q]) * w0[2 * q] + bf_lo(gc[q]) * w1[2 * q] + bf_lo(gr[q]) * w2[2 * q] + cb[2 * q];
                    const float xh = bf_hi(gl[q]) * w0[2 * q + 1] + bf_hi(gc[q]) * w1[2 * q + 1] + bf_hi(gr[q]) * w2[2 * q + 1] + cb[2 * q + 1];
                    res[2 * q] = xl / (1.0f + __expf(-xl)) * bf_lo(uu[i][q]); res[2 * q + 1] = xh / (1.0f + __expf(-xh)) * bf_hi(uu[i][q]); }
                u32x4 o; o.x = pk2(res[0], res[1]); o.y = pk2(res[2], res[3]); o.z = pk2(res[4], res[5]); o.w = pk2(res[6], res[7]);
                *(u32x4*)(Ub + (size_t)rr * DFF + f0) = o;
                gp = gc; gc = gn[i]; }
        }
    }
}
constexpr int N_PHASES = 8;
constexpr int N_LAUNCHES = MK_N_LAUNCHES;
struct StridedSched {
    int n, first, stride, npm;
    __device__ __forceinline__ bool next(int i, Unit& u) const { const int idx = first + i * stride; if (idx >= n) return false; u.pm = idx % npm; u.pn = idx / npm; return true; }
    __device__ __forceinline__ void a_ready(const Unit&) const {}
    __device__ __forceinline__ void done(const Unit&) const {}
};
__device__ __forceinline__ bool attn_next(int vcu, int G, int i, int& kind, int& idx) {
    if (G == 256) {
        if (vcu < 128) { if (i >= 2) return false; kind = 0; idx = 2 * vcu + i; return true; }
        const int v = vcu - 128;
        if (i == 0) { kind = 0; idx = 256 + v; return true; }
        if (v < 64 || i > 3) return false;
        kind = 1; idx = 3 * (v - 64) + i - 1; return true;
    }
    const int l = vcu + i * G; if (l >= 576) return false;
    if (l < 384) { kind = 0; idx = l; } else { kind = 1; idx = l - 384; }
    return true;
}
__global__ void __launch_bounds__(NWAVES * 64, 2) mk_fwd(Params P) {
    extern __shared__ __attribute__((aligned(16))) unsigned char lds_raw[];
    LAS unsigned char* lds = (LAS unsigned char*)lds_raw;
    const int tid = threadIdx.x, lane = tid & 63, wave = __builtin_amdgcn_readfirstlane(tid >> 6);
    const int G = gridDim.x, bx = blockIdx.x, vcu = (G % 8 == 0) ? (bx % 8) * (G / 8) + bx / 8 : bx;
    volatile LAS unsigned* MISC = (volatile LAS unsigned*)(lds + MISC_OFF);
    unsigned char* ws = P.ws;
    unsigned* ctl = (unsigned*)(ws + WS_CTL);
    for (int u = tid; u < (LDS_BYTES - LDSCTL_OFF) / 4; u += NWAVES * 64) ((LAS unsigned*)(lds + LDSCTL_OFF))[u] = 0u;
    __syncthreads();
    XcdBarrier bar; bar.bar = ctl + CW_BAR + P.li * XCD_BAR_WORDS; bar.x = 0; bar.st = nullptr;
    if (N_LAUNCHES != N_PHASES) bar = xcd_barrier_post(ctl + CW_BAR + P.li * XCD_BAR_WORDS, MISC + 8);
#define GRID_BAR() do { if (N_LAUNCHES != N_PHASES) xcd_barrier(bar); } while (0)
    const int lo = P.ph_lo, hi = P.ph_hi;
#ifndef PHASE_MASK
#define PHASE_MASK 0xff
#endif
#define IN(k) (((PHASE_MASK >> (k)) & 1) && lo <= (k) && (k) < hi)
#define BOTH(k) (IN(k) && IN((k) + 1))

    if (IN(0)) { p0_prep(P, lds, tid, lane, wave, vcu, G); if (BOTH(0)) GRID_BAR(); }
    if (IN(1)) { p1_norm(P, lds, tid, lane, wave, vcu, G); if (BOTH(1)) GRID_BAR(); }
    if (IN(2)) {
        pg8::Gemm g{(const bf16_t*)(ws + WS_H), (const bf16_t*)(ws + WS_WIN), NTOK, DIN, DM}; pg8::StaticOrder S; S.init(NTOK, DIN, G, bx);
        EpiInProj E{ws, P.out + (size_t)NTOK * DM, P.out + (size_t)NTOK * DM + (size_t)16 * NH * SP * 128, P.qg, P.kg};
        pg8::gemm_phase<EpiInProj, pg8::StaticOrder, true, true>(lds + RING_OFF, g, S, E);
        if (BOTH(2)) GRID_BAR();
    }
    if (IN(3)) {
        float lam, negref;
        { const float a = wave_sum(P.lq1[lane] * P.lk1[lane]), b2 = wave_sum(P.lq2[lane] * P.lk2[lane]); lam = expf(a) - expf(b2) + LAM_INIT;
          const float gq = wave_max(fabsf(P.qg[lane])), gk = wave_max(fabsf(P.kg[lane]));
          const float kmax2 = __uint_as_float(__hip_atomic_load(ctl + CW_KMAX, RLX_AGENT)); const float kmax = fmaxf(8.0f * gk, sqrtf(kmax2));
          negref = -(C2 * 8.0f * gq * kmax * 1.01f + 0.25f); }
#ifndef ATTN_OFF
        for (int i = 0; ; ++i) {
            int kind, idx; if (!attn_next(vcu, G, i, kind, idx)) break;
            const int bh = kind ? idx >> 1 : idx >> 3, qb = kind ? idx & 1 : idx & 7, b = bh / NH, h = bh - b * NH;
            const int Sq = kind ? SP : SS, Sk = kind ? SP : SKS;
            const bf16_t* Qh = (const bf16_t*)(ws + (kind ? WS_Q_P : WS_Q_S)) + (size_t)bh * 2 * Sq * 64;
            const bf16_t* Kh = (const bf16_t*)(ws + (kind ? WS_K_P : WS_K_S)) + (size_t)bh * 2 * Sk * 64;
            const bf16_t* Vh = (const bf16_t*)(ws + (kind ? WS_V_P : WS_V_S)) + (size_t)bh * Sk * 128;
            bf16_t* outp = (bf16_t*)(ws + WS_MIX) + (size_t)((kind ? 0 : NTOK_P) + b * Sq) * KOUT + 512 + h * 128;
            attn::attn_unit(lds, Qh, Kh, Vh, Sq, Sk, qb * 128, outp, lam, negref, P.subg);
        }
#endif
#ifndef FOURIER_OFF
        __syncthreads();
        { pg8::Gemm g{(const bf16_t*)(ws + WS_DFTS), (const bf16_t*)(ws + WS_XFT_S), 2048, 2048, SS};
          StridedSched S = (G == 256) ? StridedSched{64, (vcu >= 128 && vcu < 192) ? vcu - 128 : 64, 64, 8} : StridedSched{64, vcu, G, 8};
          EpiFourier E{(bf16_t*)(ws + WS_MIX), SS, NTOK_P};
          pg8::gemm_phase<EpiFourier, StridedSched, true, true>(lds + RING_OFF, g, S, E); }
        __syncthreads();
        { pg8::Gemm g{(const bf16_t*)(ws + WS_DFTP), (const bf16_t*)(ws + WS_XFT_P), 512, 4096, SP};
          StridedSched S = (G == 256) ? StridedSched{32, (vcu >= 192 && vcu < 224) ? vcu - 192 : 32, 32, 2} : StridedSched{32, vcu, G, 2};
          EpiFourier E{(bf16_t*)(ws + WS_MIX), SP, 0};
          pg8::gemm_phase<EpiFourier, StridedSched, true, true>(lds + RING_OFF, g, S, E); }
#endif
        if (BOTH(3)) GRID_BAR();
    }
    if (IN(4)) {
        pg8::Gemm g{(const bf16_t*)(ws + WS_MIX), (const bf16_t*)(ws + WS_WOUT), NTOK, DM, KOUT}; pg8::StaticOrder S; S.init(NTOK, DM, G, bx);
        EpiOut E{P};
        pg8::gemm_phase<EpiOut, pg8::StaticOrder, true, true>(lds + RING_OFF, g, S, E);
        { const int nt4 = (NTOK / 256) * (DM / 256), nidle = G - nt4;
          if (nidle > 0) { if (bx >= nt4) ffn_weight_items(P, lds, lane, wave, (bx - nt4) * NWAVES + wave, nidle * NWAVES); }
          else ffn_weight_items(P, lds, lane, wave, bx * NWAVES + wave, G * NWAVES); }
        if (BOTH(4)) GRID_BAR();
    }
    if (IN(5)) {
        pg8::Gemm g{(const bf16_t*)(ws + WS_H), (const bf16_t*)(ws + WS_WGU), NTOK, NGU, DM}; pg8::StaticOrder S; S.init(NTOK, NGU, G, bx);
        EpiGU E{ws};
        pg8::gemm_phase<EpiGU, pg8::StaticOrder, true, true>(lds + RING_OFF, g, S, E);
        if (BOTH(5)) GRID_BAR();
    }
    if (IN(6)) { p6_act(P, tid, G); if (BOTH(6)) GRID_BAR(); }
    if (IN(7)) {
        pg8::Gemm g{(const bf16_t*)(ws + WS_U), (const bf16_t*)(ws + WS_WDN), NTOK, DM, DFF}; pg8::StaticOrder S; S.init(NTOK, DM, G, bx);
        EpiDown E{ws, P.out};
        pg8::gemm_phase<EpiDown, pg8::StaticOrder, true, true>(lds + RING_OFF, g, S, E);
    }
#undef IN
#undef BOTH
#undef GRID_BAR
}

extern "C" void kernel_launch(void* const* d_in, const int* in_sizes, int n_in, void* d_out, int out_size, void* d_ws, size_t ws_size, hipStream_t stream) {
    static int ok = 0;
    if (ok == 0) {
        if (n_in != 24 || ws_size < WS_END) { fprintf(stderr, "kernel_launch: expected 24 inputs and >= %zu bytes of workspace; got %d, %zu\n", (size_t)WS_END, n_in, ws_size); ok = -1; return; }
        if (hipFuncSetAttribute((const void*)mk_fwd, hipFuncAttributeMaxDynamicSharedMemorySize, LDS_BYTES) != hipSuccess) { fprintf(stderr, "kernel_launch: hipFuncSetAttribute failed\n"); ok = -1; return; }
        int per_cu = 0;
        if (hipOccupancyMaxActiveBlocksPerMultiprocessor(&per_cu, (const void*)mk_fwd, NWAVES * 64, LDS_BYTES) != hipSuccess || per_cu < 1) fprintf(stderr, "kernel_launch: note: occupancy query reports %d workgroups per CU\n", per_cu);
        (void)hipGetLastError();
        ok = 1;
    }
    if (ok < 0) return;
    (void)hipMemsetAsync((char*)d_ws + WS_CTL, 0, CTL_ZERO_BYTES, stream);
    Params a{};
    const float** pp = (const float**)&a;
    for (int i = 0; i < 24; ++i) pp[i] = (const float*)d_in[i];
    a.out = (float*)d_out; a.ws = (unsigned char*)d_ws;
#ifdef PROBE_PHASE
#ifndef PROBE_HI
#define PROBE_HI PROBE_PHASE
#endif
    const int nl = 2; const int plo[2] = {0, PROBE_PHASE}, phi[2] = {PROBE_HI + 1, N_PHASES};
#else
    const int nl = N_LAUNCHES; int plo[N_PHASES], phi[N_PHASES];
    for (int li = 0; li < N_LAUNCHES; ++li) { plo[li] = (N_LAUNCHES == 1) ? 0 : li; phi[li] = (N_LAUNCHES == 1) ? N_PHASES : li + 1; }
#endif
    for (int li = 0; li < nl; ++li) {
        a.ph_lo = plo[li]; a.ph_hi = phi[li]; a.li = li; a.pad = 0;
        hipLaunchKernelGGL(mk_fwd, dim3(256), dim3(NWAVES * 64), LDS_BYTES, stream, a);
        const hipError_t le = hipPeekAtLastError();
        if (le != hipSuccess) { fprintf(stderr, "kernel_launch: launch %d failed: %s\n", li, hipGetErrorName(le)); break; }
    }
}
```

```cpp
#include <hip/hip_runtime.h>
#include <cstdio>
#include <cstdint>

#ifndef MK_N_LAUNCHES
#define MK_N_LAUNCHES 1
#endif
#define LAS __attribute__((address_space(3)))
#define GAS __attribute__((address_space(1)))
typedef unsigned short bf16_t;
typedef short bf16x8 __attribute__((ext_vector_type(8)));
typedef short s16x4 __attribute__((ext_vector_type(4)));
typedef float f32x2 __attribute__((ext_vector_type(2)));
typedef float f32x4 __attribute__((ext_vector_type(4)));
typedef float f32x16 __attribute__((ext_vector_type(16)));
typedef unsigned u32x2 __attribute__((ext_vector_type(2)));
typedef unsigned u32x4 __attribute__((ext_vector_type(4)));
typedef __bf16 bf16x2_t __attribute__((ext_vector_type(2)));
typedef GAS unsigned gu32;
#define RLX_AGENT __ATOMIC_RELAXED, __HIP_MEMORY_SCOPE_AGENT
#define LDS_WAIT() asm volatile("s_waitcnt lgkmcnt(0)" ::: "memory")
#define VM_WAIT() asm volatile("s_waitcnt vmcnt(0)" ::: "memory")
__device__ __forceinline__ unsigned pk2(float lo, float hi) { f32x2 v = {lo, hi}; bf16x2_t b = __builtin_convertvector(v, bf16x2_t); return __builtin_bit_cast(unsigned, b); }
__device__ __forceinline__ bf16_t f2bf(float x) { return (bf16_t)(pk2(x, 0.f) & 0xffffu); }
__device__ __forceinline__ float wave_sum(float v) {
#pragma unroll
    for (int o = 1; o < 64; o <<= 1) v += __shfl_xor(v, o);
    return v;
}
__device__ __forceinline__ float wave_max(float v) {
#pragma unroll
    for (int o = 1; o < 64; o <<= 1) v = fmaxf(v, __shfl_xor(v, o));
    return v;
}

constexpr int DM = 1024, NTOK = 12288, NTOK_P = 4096, NH = 6;
constexpr int SP = 256, SS = 1024, SKS = 1536, PAST = 512;
constexpr int DIN = 2560, DFF = 2816, KOUT = 1280, NGU = 5632, NADA = 6144;
constexpr float EPS = 1e-6f;
constexpr float C2 = 0.125f * 1.4426950408889634f;
constexpr float ONE_M_LAMINIT = 0.8f, LAM_INIT = 0.2f;

constexpr size_t MiB = 1u << 20;
constexpr size_t WS_CTL = 0, CTL_ZERO_BYTES = 1 * MiB;
constexpr size_t WS_ADA = 1 * MiB;
constexpr size_t WS_BIAS2 = 1 * MiB + 256 * 1024;
constexpr size_t WS_ROPE = 1 * MiB + 512 * 1024;
constexpr size_t WS_SSQ = 512 * 1024;
constexpr size_t WS_WIN = 3 * MiB;
constexpr size_t WS_WOUT = 8 * MiB;
constexpr size_t WS_WGU = 11 * MiB;
constexpr size_t WS_WDN = 22 * MiB;
constexpr size_t WS_DFTS = 28 * MiB;
constexpr size_t WS_DFTP = 32 * MiB;
constexpr size_t WS_H = 33 * MiB;
constexpr size_t WS_XFT_P = 58 * MiB, WS_XFT_S = 60 * MiB;
constexpr size_t WS_Q_P = 64 * MiB, WS_Q_S = 70 * MiB;
constexpr size_t WS_K_P = 82 * MiB, WS_K_S = 88 * MiB;
constexpr size_t WS_V_P = 106 * MiB, WS_V_S = 112 * MiB;
constexpr size_t WS_MIX = 130 * MiB;
constexpr size_t WS_U = 124 * MiB;
constexpr size_t WS_X1 = 190 * MiB;
constexpr size_t WS_END = 238 * MiB;
constexpr int CW_TMO = 0, CW_CODE = 1, CW_KMAX = 64, CW_BAR = 4096;

constexpr int RING_OFF = 0, RING_BYTES = 131072;
constexpr int ATT_WSC_OFF = RING_BYTES;
constexpr int LDSCTL_OFF = RING_BYTES + 2048, MISC_OFF = LDSCTL_OFF + 320;
constexpr int LDS_BYTES = 147456;
constexpr int NWAVES = 8;
namespace pg8 {
#define PG8_LAS __attribute__((address_space(3)))
typedef unsigned short bf16_t;
typedef short bf16x8 __attribute__((ext_vector_type(8)));
typedef float f32x4 __attribute__((ext_vector_type(4)));
typedef unsigned u32x4 __attribute__((ext_vector_type(4)));
constexpr int BM = 256, BK = 64, HALF = 128, HTB = HALF * BK * 2  , STAGE_BYTES = 8 * HTB, NXCD = 8, WGM = 8;

__host__ __device__ __forceinline__ int lds_byte(int r, int c) { const int st = (r >> 4) * 2 + (c >> 5), rr = r & 15, cc = c & 31, ob = rr * 64 + cc * 2; return st * 1024 + (ob ^ (((ob >> 9) & 1) << 5)); }
__host__ __device__ __forceinline__ void stage_rc(int b, int& R, int& C) { const int st = b / 1024, sb = b % 1024, swz = sb ^ (((sb >> 9) & 1) << 5); R = (st >> 1) * 16 + swz / 64; C = (st & 1) * 32 + (swz % 64) / 2; }
__host__ __device__ __forceinline__ int perm32(int rho) { const int n = rho >> 4, i = rho & 15; return 8 * (i >> 2) + 4 * n + (i & 3); }

struct Unit { int pm, pn; };
struct Gemm { const bf16_t* A; const bf16_t* Bt; int M, N, K; };

struct StaticOrder {
    int nM, nN, nwg, G, c;
    __host__ __device__ void init(int M, int N, int G_, int c_) { nM = M / BM; nN = N / BM; nwg = nM * nN; G = G_; c = c_; }
    __host__ __device__ bool next(int i, Unit& u) const {
        const long L = (long)i * G + c; if (L >= nwg) return false;
        int wgid = (int)L; { const int q = nwg / NXCD, r = nwg % NXCD, xcd = wgid % NXCD, off = wgid / NXCD; wgid = (xcd < r ? xcd * (q + 1) : r * (q + 1) + (xcd - r) * q) + off; }
        const int nig = WGM * nN, gid = wgid / nig, fm = gid * WGM, gsz = (nM - fm) < WGM ? (nM - fm) : WGM;
        u.pm = fm + ((wgid % nig) % gsz); u.pn = (wgid % nig) / gsz; return true;
    }
    __device__ __forceinline__ void a_ready(const Unit&) const {}
    __device__ __forceinline__ void done(const Unit&) const {}
};

__device__ __forceinline__ unsigned cvt_pk_bf16(float lo, float hi) { unsigned r; asm volatile("v_cvt_pk_bf16_f32 %0, %1, %2" : "=v"(r) : "v"(lo), "v"(hi)); return r; }
template <class Epi, class Sched, bool ALIGN_EPI = false, bool SP2 = false>
__device__ __forceinline__ void gemm_phase(PG8_LAS unsigned char* lds, const Gemm g, const Sched& S, const Epi& E) {
    const int tid = threadIdx.x, wid = __builtin_amdgcn_readfirstlane(tid >> 6), lane = tid & 63, wr = wid >> 2, wc = wid & 3, fr = lane & 15, fq = lane >> 4;
    const int K = g.K, nt = K / BK;
    unsigned voffA[2], voffB[2];
#pragma unroll
    for (int i = 0; i < 2; ++i) { int R, C; stage_rc(tid * 16 + i * 8192, R, C); const int Rb = Epi::PERM ? ((R & ~31) + perm32(R & 31)) : R;
        voffA[i] = (unsigned)(R * K + C) * 2u; voffB[i] = (unsigned)(Rb * K + C) * 2u; }
    const size_t kstep = (size_t)(BK * 2);
    const size_t hstep = (size_t)HALF * K * 2;
    const size_t tstep = 2 * hstep;
    const unsigned ldsw = (unsigned)wid * 1024u;
    const int aoff = lds_byte(wr * 64 + fr, fq * 8), boff = lds_byte(wc * 32 + fr, fq * 8);
#define PG8_SA(b, h) (((b) * 2 + (h)) * HTB)
#define PG8_SB(b, h) ((4 + (b) * 2 + (h)) * HTB)
#define PG8_STAGE(bufoff, gbase, voff) do { _Pragma("unroll") for (int _i = 0; _i < 2; ++_i) \
        __builtin_amdgcn_global_load_lds((const unsigned*)((const char*)(gbase) + (voff)[_i]), (PG8_LAS unsigned*)(lds + (bufoff) + ldsw + _i * 8192), 16, 0, 0); } while (0)
#define PG8_LDA(dst, b, h) do { _Pragma("unroll") for (int m = 0; m < 4; ++m) _Pragma("unroll") for (int k = 0; k < 2; ++k) dst[m][k] = *(const PG8_LAS bf16x8*)(lds + PG8_SA(b, h) + aoff + m * 2048 + k * 1024); } while (0)
#define PG8_LDB(dst, b, h) do { _Pragma("unroll") for (int n = 0; n < 2; ++n) _Pragma("unroll") for (int k = 0; k < 2; ++k) dst[n][k] = *(const PG8_LAS bf16x8*)(lds + PG8_SB(b, h) + boff + n * 2048 + k * 1024); } while (0)
#define PG8_MMA(ai, bj, At, Bt) do { __builtin_amdgcn_s_setprio(1); _Pragma("unroll") for (int m = 0; m < 4; ++m) _Pragma("unroll") for (int n = 0; n < 2; ++n) _Pragma("unroll") for (int k = 0; k < 2; ++k) \
        acc[ai][bj][m][n] = __builtin_amdgcn_mfma_f32_16x16x32_bf16(Bt[n][k], At[m][k], acc[ai][bj][m][n], 0, 0, 0); __builtin_amdgcn_s_setprio(0); } while (0)
#define PG8_WAIT_V(n) asm volatile("s_waitcnt vmcnt(" #n ")" ::: "memory")
#define PG8_WAIT_L(n) asm volatile("s_waitcnt lgkmcnt(" #n ")" ::: "memory")
#define PG8_BAR __builtin_amdgcn_s_barrier()
#define PG8_SCHED __builtin_amdgcn_sched_barrier(0)
    Unit cur, nxt; int ui = 0;
    if (!S.next(0, cur)) return;
    f32x4 acc[2][2][4][2];
#pragma unroll
    for (int a = 0; a < 2; ++a)
#pragma unroll
        for (int b = 0; b < 2; ++b)
#pragma unroll
            for (int m = 0; m < 4; ++m)
#pragma unroll
                for (int n = 0; n < 2; ++n) acc[a][b][m][n] = (f32x4){0.f, 0.f, 0.f, 0.f};
    bf16x8 At[4][2], B0[2][2], B1[2][2];
    const char* cA = (const char*)g.A + (size_t)cur.pm * tstep; const char* cB = (const char*)g.Bt + (size_t)cur.pn * tstep;
    S.a_ready(cur);
    if constexpr (SP2) {
        PG8_STAGE(PG8_SB(0, 0), cB, voffB); PG8_STAGE(PG8_SB(0, 1), cB + hstep, voffB); PG8_STAGE(PG8_SA(0, 0), cA, voffA); PG8_STAGE(PG8_SA(0, 1), cA + hstep, voffA);
        if (wr == 1) PG8_BAR;
        PG8_WAIT_V(2); PG8_BAR;
        PG8_STAGE(PG8_SB(1, 0), cB + kstep, voffB); PG8_STAGE(PG8_SA(1, 0), cA + kstep, voffA); PG8_STAGE(PG8_SB(1, 1), cB + hstep + kstep, voffB);
        PG8_WAIT_V(6); PG8_BAR;
    } else {
        PG8_STAGE(PG8_SB(0, 0), cB, voffB); PG8_STAGE(PG8_SA(0, 0), cA, voffA); PG8_STAGE(PG8_SB(0, 1), cB + hstep, voffB); PG8_STAGE(PG8_SA(0, 1), cA + hstep, voffA);
        if (wr == 1) PG8_BAR;
        PG8_WAIT_V(4); PG8_BAR;
        PG8_STAGE(PG8_SB(1, 0), cB + kstep, voffB); PG8_STAGE(PG8_SA(1, 0), cA + kstep, voffA); PG8_STAGE(PG8_SB(1, 1), cB + hstep + kstep, voffB);
        PG8_WAIT_V(6); PG8_BAR;
    }
    for (;;) {
        const bool has_next = S.next(ui + 1, nxt);
        const char* nA = has_next ? (const char*)g.A + (size_t)nxt.pm * tstep : cA; const char* nB = has_next ? (const char*)g.Bt + (size_t)nxt.pn * tstep : cB;
        for (int t = 0; t < nt; t += 2) {
            const bool last = (t == nt - 2);
            const char* a1 = cA + (size_t)(t + 1) * kstep;
            const char* a2 = last ? nA : cA + (size_t)(t + 2) * kstep; const char* b2 = last ? nB : cB + (size_t)(t + 2) * kstep;
            const char* a3 = a2 + kstep; const char* b3 = b2 + kstep;
            if (last && has_next) S.a_ready(nxt);
            if constexpr (SP2) {
            PG8_LDB(B0, 0, 0); PG8_LDB(B1, 0, 1); PG8_SCHED; PG8_LDA(At, 0, 0); PG8_STAGE(PG8_SA(1, 1), a1 + hstep, voffA);
            PG8_WAIT_V(8); PG8_WAIT_L(0); PG8_BAR; PG8_MMA(0, 0, At, B0); PG8_MMA(0, 1, At, B1); PG8_BAR; PG8_SCHED;
            PG8_LDA(At, 0, 1); PG8_STAGE(PG8_SB(0, 0), b2, voffB); PG8_STAGE(PG8_SB(0, 1), b2 + hstep, voffB); PG8_STAGE(PG8_SA(0, 0), a2, voffA);
            PG8_WAIT_V(8); PG8_WAIT_L(0); PG8_BAR; PG8_MMA(1, 0, At, B0); PG8_MMA(1, 1, At, B1); PG8_BAR; PG8_SCHED;
            PG8_LDB(B0, 1, 0); PG8_LDB(B1, 1, 1); PG8_SCHED; PG8_LDA(At, 1, 0); PG8_STAGE(PG8_SA(0, 1), a2 + hstep, voffA);
            PG8_WAIT_V(8); PG8_WAIT_L(0); PG8_BAR; PG8_MMA(0, 0, At, B0); PG8_MMA(0, 1, At, B1); PG8_BAR; PG8_SCHED;
            PG8_LDA(At, 1, 1); PG8_STAGE(PG8_SB(1, 0), b3, voffB); PG8_STAGE(PG8_SB(1, 1), b3 + hstep, voffB); PG8_STAGE(PG8_SA(1, 0), a3, voffA);
            PG8_WAIT_V(8); PG8_WAIT_L(0); PG8_BAR; PG8_MMA(1, 0, At, B0); PG8_MMA(1, 1, At, B1); PG8_BAR; PG8_SCHED;
            } else {
            PG8_LDB(B0, 0, 0); PG8_SCHED; PG8_LDA(At, 0, 0); PG8_STAGE(PG8_SA(1, 1), a1 + hstep, voffA);
            PG8_WAIT_L(8); PG8_BAR; PG8_WAIT_L(0); PG8_MMA(0, 0, At, B0); PG8_BAR; PG8_SCHED;
            PG8_LDB(B1, 0, 1); PG8_STAGE(PG8_SB(0, 0), b2, voffB);
            PG8_BAR; PG8_WAIT_L(0); PG8_MMA(0, 1, At, B1); PG8_BAR;
            PG8_LDA(At, 0, 1); PG8_STAGE(PG8_SA(0, 0), a2, voffA);
            PG8_BAR; PG8_WAIT_L(0); PG8_MMA(1, 0, At, B0); PG8_BAR; PG8_SCHED;
            PG8_STAGE(PG8_SB(0, 1), b2 + hstep, voffB);
            PG8_WAIT_V(6); PG8_BAR; PG8_MMA(1, 1, At, B1); PG8_BAR;
            PG8_LDB(B0, 1, 0); PG8_SCHED; PG8_LDA(At, 1, 0); PG8_STAGE(PG8_SA(0, 1), a2 + hstep, voffA);
            PG8_WAIT_L(8); PG8_BAR; PG8_WAIT_L(0); PG8_MMA(0, 0, At, B0); PG8_BAR; PG8_SCHED;
            PG8_LDB(B1, 1, 1); PG8_STAGE(PG8_SB(1, 0), b3, voffB);
            PG8_BAR; PG8_WAIT_L(0); PG8_MMA(0, 1, At, B1); PG8_BAR;
            PG8_LDA(At, 1, 1); PG8_STAGE(PG8_SA(1, 0), a3, voffA);
            PG8_BAR; PG8_WAIT_L(0); PG8_MMA(1, 0, At, B0); PG8_BAR; PG8_SCHED;
            PG8_STAGE(PG8_SB(1, 1), b3 + hstep, voffB);
            PG8_WAIT_V(6); PG8_BAR; PG8_MMA(1, 1, At, B1); PG8_BAR;
            }
        }
        if constexpr (ALIGN_EPI) { if (wr == 0) PG8_BAR; }
        if constexpr (!Epi::AFTER_DRAIN) { E(acc, cur, wr, wc, fr, fq); S.done(cur); }
        if (!has_next) break;
#pragma unroll
        for (int a = 0; a < 2; ++a)
#pragma unroll
            for (int b = 0; b < 2; ++b)
#pragma unroll
                for (int m = 0; m < 4; ++m)
#pragma unroll
                    for (int n = 0; n < 2; ++n) acc[a][b][m][n] = (f32x4){0.f, 0.f, 0.f, 0.f};
        cur = nxt; cA = nA; cB = nB; ++ui;
        if constexpr (ALIGN_EPI) { if (wr == 1) PG8_BAR; }
    }
    PG8_WAIT_V(0);
    if constexpr (!ALIGN_EPI) { if (wr == 0) PG8_BAR; }
    PG8_BAR;
    if constexpr (Epi::AFTER_DRAIN) { E.fused(acc, cur, wr, wc, fr, fq, lds, wid, lane); S.done(cur); }
#undef PG8_SA
#undef PG8_SB
#undef PG8_STAGE
#undef PG8_LDA
#undef PG8_LDB
#undef PG8_MMA
#undef PG8_WAIT_V
#undef PG8_WAIT_L
#undef PG8_BAR
#undef PG8_SCHED
}
}
#define XB_TMO      128
#define XB_XCNT(j)  (256  + 64 * (j))
#define XB_XSUB(j)  (1280 + 64 * (j))
#define XB_XGEN(j)  (2304 + 64 * (j))
#define XB_TOP      3328
#define XB_TOPGEN   3392
#define XCD_BAR_WORDS 3456
#define XB_SPIN_CAP (1u << 18)

__device__ __forceinline__ unsigned xb_ld(unsigned* p)              { return __hip_atomic_load(p, __ATOMIC_RELAXED, __HIP_MEMORY_SCOPE_AGENT); }
__device__ __forceinline__ unsigned xb_add(unsigned* p, unsigned v) { return __hip_atomic_fetch_add(p, v, __ATOMIC_RELAXED, __HIP_MEMORY_SCOPE_AGENT); }
__device__ __forceinline__ unsigned xb_xcc_id() { return (unsigned)__builtin_amdgcn_s_getreg((3 << 11) | 20) & 0xFu; }
#define XB_SPIN(cond, bar) do { unsigned _sp = 0; while (cond) { __builtin_amdgcn_s_sleep(1); \
    if ((++_sp & 255u) == 0u) { if (xb_ld(&(bar)[XB_TMO])) break; if (_sp > XB_SPIN_CAP) { atomicAdd(&(bar)[XB_TMO], 1u); break; } } } } while (0)

struct XcdBarrier {
    unsigned* bar; unsigned x;
    volatile LAS unsigned* st;
};

__device__ __forceinline__ XcdBarrier xcd_barrier_post(unsigned* bar, volatile LAS unsigned* st) {
    XcdBarrier b; b.bar = bar; b.x = xb_xcc_id(); b.st = st;
    if (threadIdx.x == 0) (void)xb_add(&bar[XB_XCNT(b.x)], 1u);
    return b;
}
__device__ __forceinline__ void xcd_barrier_complete(unsigned* bar, unsigned x, unsigned& nloc, unsigned& nx) {
    const unsigned G = gridDim.x * gridDim.y * gridDim.z;
    unsigned sum, cnt, mine, sp = 0u;
    for (;;) {
        sum = 0u; cnt = 0u; mine = 0u;
#pragma unroll
        for (unsigned j = 0; j < 16; ++j) { const unsigned c = xb_ld(&bar[XB_XCNT(j)]); sum += c; cnt += (c > 0u) ? 1u : 0u; mine = (j == x) ? c : mine; }
        if (sum == G) break;
        __builtin_amdgcn_s_sleep(1);
        if ((++sp & 255u) == 0u) { if (xb_ld(&bar[XB_TMO])) break; if (sp > XB_SPIN_CAP) { atomicAdd(&bar[XB_TMO], 1u); break; } }
    }
    nloc = mine > 0u ? mine : 1u; nx = cnt > 0u ? cnt : 1u;
}

__device__ __forceinline__ void xcd_barrier(const XcdBarrier& b) {
    asm volatile("s_waitcnt vmcnt(0)" ::: "memory");
    __syncthreads();
    if (threadIdx.x == 0) {
        unsigned* bar = b.bar;
        __builtin_amdgcn_s_waitcnt(0);
        unsigned nloc = b.st[0], nx = b.st[1];
        if (nloc == 0u) { xcd_barrier_complete(bar, b.x, nloc, nx); b.st[0] = nloc; b.st[1] = nx; }
        const unsigned old = xb_add(&bar[XB_XSUB(b.x)], 1u);
        const unsigned gen = old / nloc;
        if (old + 1u == (gen + 1u) * nloc) {
            __builtin_amdgcn_fence(__ATOMIC_RELEASE, "agent");
            asm volatile("s_waitcnt vmcnt(0)" ::: "memory");
            const unsigned og = xb_add(&bar[XB_TOP], 1u);
            const unsigned tg = og / nx;
            if (og + 1u == (tg + 1u) * nx) xb_add(&bar[XB_TOPGEN], 1u);
            else XB_SPIN(xb_ld(&bar[XB_TOPGEN]) == tg, bar);
            __builtin_amdgcn_fence(__ATOMIC_ACQUIRE, "agent");
            xb_add(&bar[XB_XGEN(b.x)], 1u);
            asm volatile("s_waitcnt vmcnt(0)" ::: "memory");
        } else {
            XB_SPIN(xb_ld(&bar[XB_XGEN(b.x)]) == gen, bar);
            __builtin_amdgcn_fence(__ATOMIC_ACQUIRE, "agent");
            asm volatile("s_waitcnt vmcnt(0)" ::: "memory");
        }
    }
    __syncthreads();
}
namespace attn {
constexpr int V_OFF = 0, K_OFF = 32768, EX_OFF = 65536;
#define ATT_KSWZ(row, colB) ((row) * 128 + ((colB) ^ ((((row) >> 1) & 7) << 4)))
#define ATT_SBAR() __builtin_amdgcn_sched_barrier(0)
__device__ __forceinline__ int crow(int r, int hi) { return (r & 3) + 8 * (r >> 2) + 4 * hi; }
__device__ __forceinline__ int v_st(int k, int c) { const int kk = (k & ~0xC) | ((k & 4) << 1) | ((k & 8) >> 1); return ((kk >> 3) * 4 + (c >> 5)) * 512 + ((kk & 7) * 32 + (c & 31)) * 2; }
__device__ __forceinline__ int v_rd_base(int lane) { return ((lane & 3) << 3) | (((lane >> 2) & 3) << 6) | (((lane >> 4) & 1) << 5) | (((lane >> 5) & 1) << 8); }
constexpr int v_rd_off(int d0, int ks, int half) { return d0 * 512 + ks * 4096 + half * 2048; }
template <int OFF> __device__ __forceinline__ s16x4 tr_read(int vb) {
    s16x4 r; asm volatile("ds_read_b64_tr_b16 %0, %1 offset:%2" : "=&v"(r) : "v"(vb), "i"(OFF) : "memory"); return r;
}
template <int D0> __device__ __forceinline__ void pv_one(f32x16& od, int vb, bf16x8 pa0, bf16x8 pa1, bf16x8 pa2, bf16x8 pa3) {
    const s16x4 l0 = tr_read<v_rd_off(D0, 0, 0)>(vb), h0 = tr_read<v_rd_off(D0, 0, 1)>(vb), l1 = tr_read<v_rd_off(D0, 1, 0)>(vb), h1 = tr_read<v_rd_off(D0, 1, 1)>(vb);
    const s16x4 l2 = tr_read<v_rd_off(D0, 2, 0)>(vb), h2 = tr_read<v_rd_off(D0, 2, 1)>(vb), l3 = tr_read<v_rd_off(D0, 3, 0)>(vb), h3 = tr_read<v_rd_off(D0, 3, 1)>(vb);
    asm volatile("s_waitcnt lgkmcnt(0)" ::: "memory"); ATT_SBAR();
#define ATT_PK(L, H) (bf16x8){L[0], L[1], L[2], L[3], H[0], H[1], H[2], H[3]}
    od = __builtin_amdgcn_mfma_f32_32x32x16_bf16(pa0, ATT_PK(l0, h0), od, 0, 0, 0);
    od = __builtin_amdgcn_mfma_f32_32x32x16_bf16(pa1, ATT_PK(l1, h1), od, 0, 0, 0);
    od = __builtin_amdgcn_mfma_f32_32x32x16_bf16(pa2, ATT_PK(l2, h2), od, 0, 0, 0);
    od = __builtin_amdgcn_mfma_f32_32x32x16_bf16(pa3, ATT_PK(l3, h3), od, 0, 0, 0);
#undef ATT_PK
}
__device__ __forceinline__ void pv_all(f32x16* o, int vb, bf16x8 pa0, bf16x8 pa1, bf16x8 pa2, bf16x8 pa3) {
    pv_one<0>(o[0], vb, pa0, pa1, pa2, pa3); pv_one<1>(o[1], vb, pa0, pa1, pa2, pa3); pv_one<2>(o[2], vb, pa0, pa1, pa2, pa3); pv_one<3>(o[3], vb, pa0, pa1, pa2, pa3);
}
__device__ __forceinline__ void qkt(f32x16& p0, f32x16& p1, const LAS unsigned char* Kt, const bf16x8* qr, float negref, int r32, int hi) {
#pragma unroll
    for (int r = 0; r < 16; ++r) { p0[r] = negref; p1[r] = negref; }
#pragma unroll
    for (int d0 = 0; d0 < 4; ++d0) { const int cb = (d0 * 16 + hi * 8) * 2;
        const bf16x8 b0 = *(const LAS bf16x8*)(Kt + ATT_KSWZ(r32, cb));
        const bf16x8 b1 = *(const LAS bf16x8*)(Kt + ATT_KSWZ(32 + r32, cb));
        p0 = __builtin_amdgcn_mfma_f32_32x32x16_bf16(b0, qr[d0], p0, 0, 0, 0);
        p1 = __builtin_amdgcn_mfma_f32_32x32x16_bf16(b1, qr[d0], p1, 0, 0, 0); }
}
__device__ __forceinline__ void exp_half(f32x16& p) {
#pragma unroll
    for (int r = 0; r < 16; ++r) p[r] = __builtin_amdgcn_exp2f(p[r]);
}
__device__ __forceinline__ void finish_sm(f32x16& p0, f32x16& p1, float& l_reg, bf16x8& pa0, bf16x8& pa1, bf16x8& pa2, bf16x8& pa3) {
    exp_half(p1);
    float ps = 0.f;
#pragma unroll
    for (int r = 0; r < 16; ++r) ps += p0[r];
#pragma unroll
    for (int r = 0; r < 16; ++r) ps += p1[r];
    l_reg += ps;
#define ATT_PK4(P, BASE, OUT) do { unsigned a0 = pk2(P[BASE + 0], P[BASE + 1]), a1 = pk2(P[BASE + 2], P[BASE + 3]);   \
    unsigned b0 = pk2(P[BASE + 4], P[BASE + 5]), b1 = pk2(P[BASE + 6], P[BASE + 7]);                              \
    auto r0 = __builtin_amdgcn_permlane32_swap(a0, b0, false, false); auto r1 = __builtin_amdgcn_permlane32_swap(a1, b1, false, false); \
    u32x4 w = {r0[0], r1[0], r0[1], r1[1]}; OUT = __builtin_bit_cast(bf16x8, w); } while (0)
    ATT_PK4(p0, 0, pa0); ATT_PK4(p0, 8, pa1); ATT_PK4(p1, 0, pa2); ATT_PK4(p1, 8, pa3);
#undef ATT_PK4
}

__device__ __forceinline__ void attn_unit(LAS unsigned char* lds, const bf16_t* __restrict__ Qh, const bf16_t* __restrict__ Kh, const bf16_t* __restrict__ Vh,
                                          int Sq, int Sk, int q0, bf16_t* __restrict__ outp, float lam, float negref, const float* __restrict__ subg) {
    const int tid = threadIdx.x, wid = __builtin_amdgcn_readfirstlane(tid >> 6), lane = tid & 63, r32 = lane & 31, hi = lane >> 5;
    const int comp = wid >> 2, qs = wid & 3;
    LAS unsigned char* V_lds = lds + V_OFF; LAS unsigned char* K_lds = lds + K_OFF;
    LAS float* wsf = (LAS float*)(lds + ATT_WSC_OFF) + wid * 64;
    bf16x8 qr[4];
    { const bf16_t* Qw = Qh + ((size_t)comp * Sq + q0 + qs * 32 + r32) * 64 + hi * 8;
#pragma unroll
      for (int d0 = 0; d0 < 4; ++d0) qr[d0] = *(const bf16x8*)(Qw + d0 * 16); }
    const int krow = tid >> 3, kcb = (tid & 7) * 16, kst = ATT_KSWZ(krow, kcb);
    const int sr = tid >> 4, sc = (tid & 15) * 8, vst0 = v_st(sr, sc), vst1 = v_st(32 + sr, sc);
    const bf16_t* Kg0 = Kh + tid * 8; const bf16_t* Kg1 = Kh + (size_t)Sk * 64 + tid * 8;
    const bf16_t* Vg0 = Vh + (size_t)sr * 128 + sc; const bf16_t* Vg1 = Vh + (size_t)(32 + sr) * 128 + sc;
    const int vb0 = (int)(unsigned)(uintptr_t)V_lds + v_rd_base(lane);
    const LAS unsigned char* Kc = K_lds + comp * 8192;
    bf16x8 sE_k0, sE_k1, sE_v0, sE_v1;
#define ATT_SLOAD(S, j) do { S##_k0 = *(const bf16x8*)(Kg0 + (size_t)(j) * 4096); S##_k1 = *(const bf16x8*)(Kg1 + (size_t)(j) * 4096); \
    S##_v0 = *(const bf16x8*)(Vg0 + (size_t)(j) * 8192); S##_v1 = *(const bf16x8*)(Vg1 + (size_t)(j) * 8192); } while (0)
#define ATT_SWRITE(b, S) do { *(LAS bf16x8*)(V_lds + (b) * 16384 + vst0) = S##_v0; *(LAS bf16x8*)(V_lds + (b) * 16384 + vst1) = S##_v1; \
    *(LAS bf16x8*)(K_lds + (b) * 16384 + kst) = S##_k0; *(LAS bf16x8*)(K_lds + (b) * 16384 + 8192 + kst) = S##_k1; } while (0)
#define ATT_SWAIT() asm volatile("s_waitcnt vmcnt(0)" ::: "memory")
    float l_reg = 0.f; f32x16 o[4];
#pragma unroll
    for (int d = 0; d < 4; ++d)
#pragma unroll
        for (int r = 0; r < 16; ++r) o[d][r] = 0.f;
    f32x16 pA0, pA1, pB0, pB1; bf16x8 pa0, pa1, pa2, pa3; const int NT = Sk / 64;
    ATT_SLOAD(sE, 0); asm volatile("s_waitcnt vmcnt(0)" ::: "memory"); ATT_SWRITE(0, sE); __syncthreads();
    qkt(pA0, pA1, Kc, qr, negref, r32, hi); exp_half(pA0);
    ATT_SLOAD(sE, 1);
    ATT_SWAIT(); ATT_SWRITE(1, sE); __syncthreads();
    for (int j = 1; j + 1 < NT; j += 2) {
        ATT_SBAR(); qkt(pB0, pB1, Kc + 16384, qr, negref, r32, hi);
        finish_sm(pA0, pA1, l_reg, pa0, pa1, pa2, pa3); ATT_SBAR();
        ATT_SLOAD(sE, j + 1); ATT_SBAR();
        pv_all(o, vb0, pa0, pa1, pa2, pa3); exp_half(pB0);
        __syncthreads(); ATT_SWAIT(); ATT_SWRITE(0, sE);
        __syncthreads();
        ATT_SBAR(); qkt(pA0, pA1, Kc, qr, negref, r32, hi);
        finish_sm(pB0, pB1, l_reg, pa0, pa1, pa2, pa3); ATT_SBAR();
        ATT_SLOAD(sE, j + 2); ATT_SBAR();
        pv_all(o, vb0 + 16384, pa0, pa1, pa2, pa3); exp_half(pA0);
        __syncthreads(); ATT_SWAIT(); ATT_SWRITE(1, sE);
        __syncthreads();
    }
    ATT_SBAR(); qkt(pB0, pB1, Kc + 16384, qr, negref, r32, hi);
    finish_sm(pA0, pA1, l_reg, pa0, pa1, pa2, pa3); ATT_SBAR();
    pv_all(o, vb0, pa0, pa1, pa2, pa3); exp_half(pB0);
    finish_sm(pB0, pB1, l_reg, pa0, pa1, pa2, pa3); ATT_SBAR();
    pv_all(o, vb0 + 16384, pa0, pa1, pa2, pa3);
#undef ATT_SLOAD
#undef ATT_SWRITE
#undef ATT_SWAIT
    { auto rr = __builtin_amdgcn_permlane32_swap(__float_as_uint(l_reg), __float_as_uint(l_reg), false, false); l_reg = __uint_as_float(rr[0]) + __uint_as_float(rr[1]); }
    int lz = lane; asm volatile("" : "+v"(lz));
    const int r32e = lz & 31, hie = lz >> 5;
    if (hie == 0) wsf[r32e] = l_reg;
    LDS_WAIT();
    float rli[16];
#pragma unroll
    for (int r = 0; r < 16; ++r) rli[r] = 1.0f / wsf[(r & 3) + 8 * (r >> 2) + 4 * hie];
    LAS float* ex = (LAS float*)(lds + EX_OFF) + qs * 4096;
    LAS float* exl = ex + lz;
    if (comp == 1) {
#pragma unroll
        for (int d0 = 0; d0 < 4; ++d0)
#pragma unroll
            for (int r = 0; r < 16; ++r) exl[(d0 * 16 + r) * 64] = o[d0][r] * rli[r];
    }
    __syncthreads();
    if (comp == 0) {
#pragma unroll
        for (int d0 = 0; d0 < 4; ++d0)
#pragma unroll
            for (int r = 0; r < 16; ++r) o[d0][r] = o[d0][r] * rli[r] - lam * exl[(d0 * 16 + r) * 64];
        LDS_WAIT(); asm volatile("" ::: "memory");
        LAS float* wb[4];
#pragma unroll
        for (int q = 0; q < 4; ++q) { const int rq = q + 4 * hie; wb[q] = ex + rq * 128 + (r32e ^ (rq << 2)); }
#pragma unroll
        for (int d0 = 0; d0 < 4; ++d0)
#pragma unroll
            for (int r = 0; r < 16; ++r) wb[r & 3][(r >> 2) * 1024 + d0 * 32] = o[d0][r];
        LDS_WAIT(); asm volatile("" ::: "memory");
        const int row2 = lz >> 1, half = lz & 1, x3 = (row2 & 7) << 2;
        const LAS float* rb = ex + row2 * 128 + 64 * half;
        f32x4 v[16]; float ss = 0.f;
#pragma unroll
        for (int i = 0; i < 16; ++i) { v[i] = *(const LAS f32x4*)(rb + ((4 * i) ^ x3)); ss += (v[i][0] * v[i][0] + v[i][1] * v[i][1]) + (v[i][2] * v[i][2] + v[i][3] * v[i][3]); }
        ss += __shfl_xor(ss, 1);
        const float rinv = rsqrtf(ss * (1.0f / 128.0f) + EPS) * ONE_M_LAMINIT;
        bf16_t* orow = outp + (size_t)(q0 + qs * 32 + row2) * KOUT + 64 * half;
        const float* sg = subg + 64 * half;
#pragma unroll
        for (int i = 0; i < 8; ++i) { const f32x4 g0 = *(const f32x4*)(sg + 8 * i), g1 = *(const f32x4*)(sg + 8 * i + 4); const f32x4 a = v[2 * i] * rinv * g0, b = v[2 * i + 1] * rinv * g1;
            u32x4 w; w.x = pk2(a[0], a[1]); w.y = pk2(a[2], a[3]); w.z = pk2(b[0], b[1]); w.w = pk2(b[2], b[3]); *(u32x4*)(orow + 8 * i) = w; }
    }
}
#undef ATT_KSWZ
#undef ATT_SBAR
}
struct Params {
    const float *x_p, *x_s, *cache_k, *cache_v, *c, *c_ctx, *n1, *n2, *w_ada, *b_ada, *w_in, *qg, *kg, *lq1, *lk1, *lq2, *lk2, *subg, *w_out, *w_gate, *w_up, *conv_w, *conv_b, *w_down;
    float* out; unsigned char* ws; int ph_lo, ph_hi, li, pad;
};
__device__ __forceinline__ int invperm32(int c) { return 16 * ((c >> 2) & 1) + 4 * (c >> 3) + (c & 3); }
__device__ __forceinline__ int rowperm(int n) { return (n & ~31) | invperm32(n & 31); }
__device__ __forceinline__ const float* xrow_ptr(const Params& P, int m) { return m < NTOK_P ? P.x_p + (size_t)m * DM : P.x_s + (size_t)(m - NTOK_P) * DM; }
__device__ __forceinline__ int modrow_of_tile(int pm) { return pm < 16 ? 0 : 1 + ((pm - 16) >> 2); }

template <int NC> __device__ __forceinline__ void gemv9_slab(const LAS float* vec, LAS float* red, const float* __restrict__ W, int ldw, int c0, const float* __restrict__ bias, float* __restrict__ out, int ldo, int oc0, int tid) {
    constexpr int NCG = NC / 4, KPAR = 512 / NCG, KP = KPAR + 1;
    const int cg = tid % NCG, ks = tid / NCG;
    float a[9][4];
#pragma unroll
    for (int j = 0; j < 9; ++j)
#pragma unroll
        for (int e = 0; e < 4; ++e) a[j][e] = 0.f;
    if (ks < KPAR) {
        constexpr int NI = (1024 + KPAR - 1) / KPAR;
        f32x4 w[NI];
#pragma unroll
        for (int i = 0; i < NI; ++i) { const int k = ks + i * KPAR; w[i] = (k < 1024) ? *(const f32x4*)(W + (size_t)k * ldw + c0 + 4 * cg) : (f32x4){0.f, 0.f, 0.f, 0.f}; }
#pragma unroll
        for (int i = 0; i < NI; ++i) { const int k = ks + i * KPAR; const int kc = k < 1024 ? k : 1023;
#pragma unroll
            for (int j = 0; j < 9; ++j) { const float v = vec[j * 1024 + kc]; a[j][0] += v * w[i][0]; a[j][1] += v * w[i][1]; a[j][2] += v * w[i][2]; a[j][3] += v * w[i][3]; }
        }
#pragma unroll
        for (int j = 0; j < 9; ++j)
#pragma unroll
            for (int e = 0; e < 4; ++e) red[(j * NC + cg * 4 + e) * KP + ks] = a[j][e];
    }
    __syncthreads();
    if (tid < 9 * NC) { float s = 0.f; for (int q = 0; q < KPAR; ++q) s += red[tid * KP + q]; const int j = tid / NC, c = tid % NC; out[(size_t)j * ldo + oc0 + c] = s + (bias ? bias[oc0 + c] : 0.f); }
    __syncthreads();
}
template <class DestRow>
__device__ __forceinline__ void transpose_item(const float* __restrict__ W, int ldw, int k0, int n0, bf16_t* __restrict__ WT, int ldt, int kd0, DestRow dest, LAS float* scr, int lane) {
    float tv[32];
#pragma unroll
    for (int i = 0; i < 32; ++i) tv[i] = W[(size_t)(k0 + 2 * i + (lane >> 5)) * ldw + n0 + (lane & 31)];
#pragma unroll
    for (int i = 0; i < 32; ++i) scr[(2 * i + (lane >> 5)) * 33 + (lane & 31)] = tv[i];
    LDS_WAIT(); asm volatile("" ::: "memory");
    const int c = lane & 7;
#pragma unroll
    for (int j = 0; j < 4; ++j) { const int n = (lane >> 3) + 8 * j; const LAS float* s = scr + (8 * c) * 33 + n;
        u32x4 o; o.x = pk2(s[0 * 33], s[1 * 33]); o.y = pk2(s[2 * 33], s[3 * 33]); o.z = pk2(s[4 * 33], s[5 * 33]); o.w = pk2(s[6 * 33], s[7 * 33]);
        *(u32x4*)(WT + (size_t)dest(n0 + n) * ldt + kd0 + 8 * c) = o; }
    LDS_WAIT(); asm volatile("" ::: "memory");
}
struct DestIn { __device__ __forceinline__ int operator()(int n) const { const int tile = n >> 8, tc = n & 255; int p;
    if (tile == 0) p = tc; else if (tile <= 6) p = 128 * ((tc >> 5) & 1) + 32 * (tc >> 6) + (tc & 31); else p = rowperm(tc); return tile * 256 + p; } };
struct DestPerm { __device__ __forceinline__ int operator()(int n) const { return rowperm(n); } };
struct DestGU { int up; __device__ __forceinline__ int operator()(int f) const { return (f >> 7) * 256 + up * 128 + rowperm(f & 127); } };
__device__ __forceinline__ void fout_item(const float* __restrict__ w_out, bf16_t* __restrict__ WT, int h, int nb, LAS float* scr, int lane) {
#pragma unroll
    for (int i = 0; i < 16; ++i) { const int d = 4 * i + (lane >> 4), j = lane & 15; scr[d * 17 + j] = w_out[(size_t)(64 * h + d) * DM + 16 * nb + j]; }
    LAS float* ctab = scr + 1088; LAS float* stab = scr + 1152;
    ctab[lane] = __builtin_amdgcn_cosf((float)lane * (1.0f / 64.0f)); stab[lane] = __builtin_amdgcn_sinf((float)lane * (1.0f / 64.0f));
    LDS_WAIT(); asm volatile("" ::: "memory");
    float ac[16], as_[16];
#pragma unroll
    for (int j = 0; j < 16; ++j) { ac[j] = 0.f; as_[j] = 0.f; }
#pragma unroll 2
    for (int d = 0; d < 64; ++d) { const int idx = (d * lane) & 63; const float cv = ctab[idx], sv = stab[idx];
#pragma unroll
        for (int j = 0; j < 16; ++j) { const float w = scr[d * 17 + j]; ac[j] += cv * w; as_[j] += sv * w; } }
#pragma unroll
    for (int j = 0; j < 16; ++j) { const int row = rowperm(16 * nb + j);
        WT[(size_t)row * KOUT + 64 * h + lane] = f2bf(ac[j] * 0.125f); WT[(size_t)row * KOUT + 256 + 64 * h + lane] = f2bf(-as_[j] * 0.125f); }
    LDS_WAIT(); asm volatile("" ::: "memory");
}

constexpr int I_TIN = 16 * 80, I_TOUT = 12 * 32, I_TG = 16 * 88, I_TU = 16 * 88, I_TDN = 44 * 32, I_FOUT = 4 * 64, I_CK = 768, I_CV = 768, I_DFTS = 4096, I_DFTP = 256, I_ROPE = 1;
constexpr int P0_ITEMS = I_TIN + I_TOUT + I_FOUT + I_CK + I_CV + I_DFTS + I_DFTP + I_ROPE;
constexpr int FFNW_ITEMS = I_TG + I_TU + I_TDN;
__device__ __forceinline__ void ffn_weight_items(const Params& P, LAS unsigned char* lds, int lane, int wave, int first, int stride) {
    LAS float* scr = (LAS float*)(lds + wave * 9216);
    bf16_t* Wt_gu = (bf16_t*)(P.ws + WS_WGU); bf16_t* Wt_dn = (bf16_t*)(P.ws + WS_WDN);
    for (int it = first; it < FFNW_ITEMS; it += stride) {
        int r = it;
        if (r < I_TG) { transpose_item(P.w_gate, DFF, 64 * (r / 88), 32 * (r % 88), Wt_gu, DM, 64 * (r / 88), DestGU{0}, scr, lane); continue; } r -= I_TG;
        if (r < I_TU) { transpose_item(P.w_up, DFF, 64 * (r / 88), 32 * (r % 88), Wt_gu, DM, 64 * (r / 88), DestGU{1}, scr, lane); continue; } r -= I_TU;
        { const int kb = r >> 5, nb = r & 31; transpose_item(P.w_down, DM, 64 * kb, 32 * nb, Wt_dn, DFF, 64 * kb, DestPerm{}, scr, lane); }
    }
}
__device__ __forceinline__ void p0_prep(const Params& P, LAS unsigned char* lds, int tid, int lane, int wave, int vcu, int G) {
    unsigned char* ws = P.ws;
    LAS float* vec = (LAS float*)lds; LAS float* red = (LAS float*)(lds + 36864);
    for (int i = tid; i < 9 * 1024; i += 512) { const int j = i >> 10, k = i & 1023; const float x = (j == 0) ? P.c_ctx[k] : P.c[(j - 1) * 1024 + k]; vec[i] = x / (1.0f + expf(-x)); }
    __syncthreads();
    for (int s = blockIdx.x; s < NADA / 24; s += G) gemv9_slab<24>(vec, red, P.w_ada, NADA, 24 * s, P.b_ada, (float*)(ws + WS_ADA), NADA, 24 * s, tid);
    __syncthreads();
    LAS float* scr = (LAS float*)(lds + wave * 9216);
    bf16_t* Wt_in = (bf16_t*)(ws + WS_WIN); bf16_t* Wt_out = (bf16_t*)(ws + WS_WOUT); bf16_t* Wt_gu = (bf16_t*)(ws + WS_WGU); bf16_t* Wt_dn = (bf16_t*)(ws + WS_WDN);
    const int gw = vcu * NWAVES + wave, NGW = G * NWAVES;
    for (int it = gw; it < P0_ITEMS; it += NGW) {
        int r = it;
        if (r < I_TIN) { transpose_item(P.w_in, DIN, 64 * (r / 80), 32 * (r % 80), Wt_in, DM, 64 * (r / 80), DestIn{}, scr, lane); continue; } r -= I_TIN;
        if (r < I_TOUT) { const int kb = r >> 5, nb = r & 31; transpose_item(P.w_out, DM, 256 + 64 * kb, 32 * nb, Wt_out, KOUT, 512 + 64 * kb, DestPerm{}, scr, lane); continue; } r -= I_TOUT;
        if (r < I_FOUT) { fout_item(P.w_out, Wt_out, r >> 6, r & 63, scr, lane); continue; } r -= I_FOUT;
        if (r < I_CK) {
            bf16_t* Ks = (bf16_t*)(ws + WS_K_S); float mx = 0.f;
            f32x4 xv[16];
#pragma unroll
            for (int j = 0; j < 16; ++j) xv[j] = *(const f32x4*)(P.cache_k + (size_t)(r * 1024 + j * 64 + lane) * 4);
#pragma unroll
            for (int j = 0; j < 16; ++j) { const int q4 = r * 1024 + j * 64 + lane, e = q4 * 4; const f32x4 x = xv[j];
                const int d = e & 63, cc = (e >> 6) & 1, p = (e >> 7) & 511, bh = e >> 16;
                u32x2 w; w.x = pk2(x[0], x[1]); w.y = pk2(x[2], x[3]); *(u32x2*)(Ks + ((size_t)(bh * 2 + cc) * SKS + 1024 + p) * 64 + d) = w;
                float ss = (x[0] * x[0] + x[1] * x[1]) + (x[2] * x[2] + x[3] * x[3]);
                ss += __shfl_xor(ss, 1); ss += __shfl_xor(ss, 2); ss += __shfl_xor(ss, 4); ss += __shfl_xor(ss, 8); mx = fmaxf(mx, ss); }
            mx = wave_max(mx);
            if (lane == 0) atomicMax((unsigned*)(ws + WS_CTL) + CW_KMAX, __float_as_uint(mx));
            continue; } r -= I_CK;
        if (r < I_CV) {
            bf16_t* Vs = (bf16_t*)(ws + WS_V_S);
            f32x4 xv[16];
#pragma unroll
            for (int j = 0; j < 16; ++j) xv[j] = *(const f32x4*)(P.cache_v + (size_t)(r * 1024 + j * 64 + lane) * 4);
#pragma unroll
            for (int j = 0; j < 16; ++j) { const int q4 = r * 1024 + j * 64 + lane, e = q4 * 4; const f32x4 x = xv[j];
                const int dv = e & 127, p = (e >> 7) & 511, bh = e >> 16;
                u32x2 w; w.x = pk2(x[0], x[1]); w.y = pk2(x[2], x[3]); *(u32x2*)(Vs + ((size_t)bh * SKS + 1024 + p) * 128 + dv) = w; }
            continue; } r -= I_CV;
        if (r < I_DFTS + I_DFTP) {
            const bool smp = r < I_DFTS; const int lg = smp ? 10 : 8, S = 1 << lg; const int item = smp ? r : r - I_DFTS; bf16_t* Dm = (bf16_t*)(ws + (smp ? WS_DFTS : WS_DFTP));
            const float sc = smp ? 0.03125f : 0.0625f, invS = 1.0f / (float)S; const int idx0 = item * 512 + lane * 8, f = idx0 >> lg, s0 = idx0 & (S - 1), kf = f & (S - 1); const bool isSin = f >= S;
            float v[8];
#pragma unroll
            for (int i = 0; i < 8; ++i) { const float fr = (float)((kf * (s0 + i)) & (S - 1)) * invS; v[i] = (isSin ? __builtin_amdgcn_sinf(fr) : __builtin_amdgcn_cosf(fr)) * sc; }
            u32x4 w; w.x = pk2(v[0], v[1]); w.y = pk2(v[2], v[3]); w.z = pk2(v[4], v[5]); w.w = pk2(v[6], v[7]); *(u32x4*)(Dm + idx0) = w;
            continue; } r -= I_DFTS + I_DFTP;
        {
            f32x2* T = (f32x2*)(ws + WS_ROPE);
#pragma unroll
            for (int j = 0; j < 16; ++j) { const int ent = j * 64 + lane, pos = ent >> 4, i = ent & 15; const float inv = powf(10000.0f, -(float)i * (1.0f / 16.0f)); const float ang = (float)pos * inv, rev = ang * 0.15915494309189535f;
                T[ent] = (f32x2){__builtin_amdgcn_cosf(rev), __builtin_amdgcn_sinf(rev)}; }
        }
    }
}

__device__ __forceinline__ void p1_norm(const Params& P, LAS unsigned char* lds, int tid, int lane, int wave, int vcu, int G) {
    unsigned char* ws = P.ws; const float* ada = (const float*)(ws + WS_ADA);
    LAS float* vec = (LAS float*)lds; LAS float* red = (LAS float*)(lds + 36864);
    for (int i = tid; i < 9 * 1024; i += 512) { const int j = i >> 10, k = i & 1023; vec[i] = ada[(size_t)j * NADA + 3072 + k]; }
    __syncthreads();
    for (int s = blockIdx.x; s < 352; s += G) { const int mat = s / 176, c0 = (s % 176) * 16;
        gemv9_slab<16>(vec, red, mat ? P.w_up : P.w_gate, DFF, c0, nullptr, (float*)(ws + WS_BIAS2), NGU, mat * DFF + c0, tid); }
    bf16_t* Hb = (bf16_t*)(ws + WS_H);
    const int gw = vcu * NWAVES + wave, NGW = G * NWAVES;
    f32x4 g1v[4];
#pragma unroll
    for (int j = 0; j < 4; ++j) g1v[j] = ((const f32x4*)P.n1)[lane + 64 * j];
    f32x4 xv[4], shv[4], scv[4];
#define P1_LOAD(m_) do { const int mr_ = (m_) < NTOK_P ? 0 : 1 + (((m_) - NTOK_P) >> 10); const f32x4* xr_ = (const f32x4*)xrow_ptr(P, (m_)) + lane; \
        const f32x4* sh_ = (const f32x4*)(ada + (size_t)mr_ * NADA) + lane; const f32x4* sc_ = (const f32x4*)(ada + (size_t)mr_ * NADA + 1024) + lane; \
        _Pragma("unroll") for (int j = 0; j < 4; ++j) { xv[j] = xr_[64 * j]; shv[j] = sh_[64 * j]; scv[j] = sc_[64 * j]; } } while (0)
    if (gw < NTOK) P1_LOAD(gw);
    for (int m = gw; m < NTOK; m += NGW) {
        f32x4 v[4], shc[4], scc[4];
#pragma unroll
        for (int j = 0; j < 4; ++j) { v[j] = xv[j]; shc[j] = shv[j]; scc[j] = scv[j]; }
        if (m + NGW < NTOK) P1_LOAD(m + NGW);
        float s = 0.f;
#pragma unroll
        for (int j = 0; j < 4; ++j) s += (v[j][0] * v[j][0] + v[j][1] * v[j][1]) + (v[j][2] * v[j][2] + v[j][3] * v[j][3]);
        const float rstd = rsqrtf(wave_sum(s) * (1.0f / DM) + EPS);
        u32x2* o8 = (u32x2*)(Hb + (size_t)m * DM) + lane;
#pragma unroll
        for (int j = 0; j < 4; ++j) { const f32x4 hv = v[j] * rstd * g1v[j] * (scc[j] + 1.0f) + shc[j]; u32x2 w; w.x = pk2(hv[0], hv[1]); w.y = pk2(hv[2], hv[3]); o8[64 * j] = w; }
    }
#undef P1_LOAD
}

using pg8::Unit;
struct EpiInProj {
    static constexpr bool PERM = false, AFTER_DRAIN = false;
    unsigned char* ws; float* newk; float* newv; const float* qg; const float* kg;
    __device__ __forceinline__ void operator()(const f32x4 (&acc)[2][2][4][2], const Unit& u, int wr, int wc, int fr_, int fq_) const {
        int fr = fr_, fq = fq_; asm volatile("" : "+v"(fr), "+v"(fq));
        const bool prompt = u.pm < 16; const int b = prompt ? u.pm : (u.pm - 16) >> 2; const int s0 = prompt ? 0 : ((u.pm - 16) & 3) * 256; const int S = prompt ? SP : SS, Sk = prompt ? SP : SKS;
        if (u.pn == 0) {
            bf16_t* base = (bf16_t*)(ws + (prompt ? WS_XFT_P : WS_XFT_S)) + (size_t)b * 256 * S;
#pragma unroll
            for (int ai = 0; ai < 2; ++ai)
#pragma unroll
                for (int m = 0; m < 4; ++m) { const int s = s0 + 128 * ai + 64 * wr + 16 * m + fr;
#pragma unroll
                    for (int bj = 0; bj < 2; ++bj)
#pragma unroll
                        for (int n = 0; n < 2; ++n)
#pragma unroll
                            for (int e = 0; e < 4; ++e) { const int ch = 128 * bj + 32 * wc + 16 * n + 4 * fq + e; base[(size_t)ch * S + s] = f2bf(acc[ai][bj][m][n][e]); } }
        } else if (u.pn <= 6) {
            const bool isq = u.pn <= 3; const int t = isq ? u.pn - 1 : u.pn - 4; const int head = 2 * t + (wc >> 1), comp = wc & 1;
            const float* gsrc = isq ? qg : kg; f32x4 g[2][2];
#pragma unroll
            for (int bj = 0; bj < 2; ++bj)
#pragma unroll
                for (int n = 0; n < 2; ++n) g[bj][n] = *(const f32x4*)(gsrc + 32 * bj + 16 * n + 4 * fq);
            bf16_t* dst = isq ? (bf16_t*)(ws + (prompt ? WS_Q_P : WS_Q_S)) + ((size_t)((b * NH + head) * 2 + comp) * S) * 64
                              : (bf16_t*)(ws + (prompt ? WS_K_P : WS_K_S)) + ((size_t)((b * NH + head) * 2 + comp) * Sk) * 64;
            const f32x2* rope = (const f32x2*)(ws + WS_ROPE);
#pragma unroll
            for (int ai = 0; ai < 2; ++ai) {
#pragma unroll
                for (int m = 0; m < 4; ++m) { const int s = s0 + 128 * ai + 64 * wr + 16 * m + fr;
                    f32x4 rt[2][2];
#pragma unroll
                    for (int bj = 0; bj < 2; ++bj) { const int pos = bj == 0 ? (s >> 6) : (s & 63); const f32x4* tp = (const f32x4*)(rope + pos * 16 + 4 * fq); rt[bj][0] = tp[0]; rt[bj][1] = tp[1]; }
                    f32x4 v[2][2]; float ss = 0.f;
#pragma unroll
                    for (int bj = 0; bj < 2; ++bj)
#pragma unroll
                        for (int n = 0; n < 2; ++n) { v[bj][n] = acc[ai][bj][m][n]; ss += (v[bj][n][0] * v[bj][n][0] + v[bj][n][1] * v[bj][n][1]) + (v[bj][n][2] * v[bj][n][2] + v[bj][n][3] * v[bj][n][3]); }
                    ss += __shfl_xor(ss, 16); ss += __shfl_xor(ss, 32);
                    const float rinv = rsqrtf(ss * (1.0f / 64.0f) + EPS);
#pragma unroll
                    for (int bj = 0; bj < 2; ++bj)
#pragma unroll
                        for (int n = 0; n < 2; ++n) v[bj][n] = v[bj][n] * rinv * g[bj][n];
                    if (!prompt) {
#pragma unroll
                        for (int bj = 0; bj < 2; ++bj) { const f32x4 t0 = rt[bj][0], t1 = rt[bj][1];
                            const float cs[4] = {t0[0], t0[2], t1[0], t1[2]}, sn[4] = {t0[1], t0[3], t1[1], t1[3]};
#pragma unroll
                            for (int e = 0; e < 4; ++e) { const float x1 = v[bj][0][e], x2 = v[bj][1][e]; v[bj][0][e] = x1 * cs[e] - x2 * sn[e]; v[bj][1][e] = x2 * cs[e] + x1 * sn[e]; } }
                    }
                    if (!isq && prompt) { float* nk = newk + ((size_t)((b * NH + head) * SP + s) * 2 + comp) * 64 + 4 * fq;
#pragma unroll
                        for (int bj = 0; bj < 2; ++bj)
#pragma unroll
                            for (int n = 0; n < 2; ++n) *(f32x4*)(nk + 32 * bj + 16 * n) = v[bj][n]; }
                    const float osc = isq ? C2 : 1.0f; bf16_t* drow = dst + (size_t)s * 64 + 4 * fq;
#pragma unroll
                    for (int bj = 0; bj < 2; ++bj)
#pragma unroll
                        for (int n = 0; n < 2; ++n) { const f32x4 x = v[bj][n] * osc; u32x2 w; w.x = pk2(x[0], x[1]); w.y = pk2(x[2], x[3]); *(u32x2*)(drow + 32 * bj + 16 * n) = w; }
                    asm volatile("" ::: "memory");
                }
            }
        } else {
            const int t = u.pn - 7;
#pragma unroll
            for (int bj = 0; bj < 2; ++bj) { const int head = 2 * t + bj;
                bf16_t* dst = (bf16_t*)(ws + (prompt ? WS_V_P : WS_V_S)) + ((size_t)(b * NH + head) * Sk) * 128 + 32 * wc + 8 * fq;
                float* nv = newv + ((size_t)(b * NH + head) * SP) * 128 + 32 * wc + 8 * fq;
#pragma unroll
                for (int ai = 0; ai < 2; ++ai)
#pragma unroll
                    for (int m = 0; m < 4; ++m) { const int s = s0 + 128 * ai + 64 * wr + 16 * m + fr; const f32x4 a = acc[ai][bj][m][0], c = acc[ai][bj][m][1];
                        u32x4 w; w.x = pk2(a[0], a[1]); w.y = pk2(a[2], a[3]); w.z = pk2(c[0], c[1]); w.w = pk2(c[2], c[3]); *(u32x4*)(dst + (size_t)s * 128) = w;
                        if (prompt) { *(f32x4*)(nv + (size_t)s * 128) = a; *(f32x4*)(nv + (size_t)s * 128 + 4) = c; } } }
        }
    }
};
struct EpiFourier {
    static constexpr bool PERM = false, AFTER_DRAIN = false;
    bf16_t* mix; int S, tok0;
    __device__ __forceinline__ void operator()(const f32x4 (&acc)[2][2][4][2], const Unit& u, int wr, int wc, int fr_, int fq_) const {
        int fr = fr_, fq = fq_; asm volatile("" : "+v"(fr), "+v"(fq));
        const int f0 = u.pm * 256, part = f0 >= S ? 1 : 0; const int k0 = f0 - part * S;
#pragma unroll
        for (int ai = 0; ai < 2; ++ai)
#pragma unroll
            for (int m = 0; m < 4; ++m) { bf16_t* rowp = mix + (size_t)(tok0 + u.pn * S + k0 + 128 * ai + 64 * wr + 16 * m + fr) * KOUT + part * 256 + 32 * wc + 4 * fq;
#pragma unroll
                for (int bj = 0; bj < 2; ++bj)
#pragma unroll
                    for (int n = 0; n < 2; ++n) { const f32x4 x = acc[ai][bj][m][n]; u32x2 w; w.x = pk2(x[0], x[1]); w.y = pk2(x[2], x[3]); *(u32x2*)(rowp + 128 * bj + 16 * n) = w; } }
    }
};
struct EpiOut {
    static constexpr bool PERM = false, AFTER_DRAIN = false;
    Params P;
    __device__ __forceinline__ void operator()(const f32x4 (&acc)[2][2][4][2], const Unit& u, int wr, int wc, int fr_, int fq_) const {
        int fr = fr_, fq = fq_; asm volatile("" : "+v"(fr), "+v"(fq));
        const float* ada = (const float*)(P.ws + WS_ADA) + (size_t)modrow_of_tile(u.pm) * NADA; bf16_t* x1s = (bf16_t*)(P.ws + WS_H); float* ssq = (float*)(P.ws + WS_SSQ);
        const int c0 = u.pn * 256 + 32 * wc + 8 * fq;
        f32x4 g1[2][2], md[2][2];
#pragma unroll
        for (int bj = 0; bj < 2; ++bj)
#pragma unroll
            for (int n = 0; n < 2; ++n) { const int c = c0 + 128 * bj + 4 * n; g1[bj][n] = *(const f32x4*)(ada + 2048 + c); md[bj][n] = *(const f32x4*)(P.n2 + c) * (*(const f32x4*)(ada + 4096 + c) + 1.0f); }
#pragma unroll
        for (int am = 0; am < 4; ++am) { const int ai = am >> 1;
            f32x4 xv[4][2][2];
#pragma unroll
            for (int m = 2 * (am & 1); m < 2 * (am & 1) + 2; ++m) { const int r = u.pm * 256 + 128 * ai + 64 * wr + 16 * m + fr; const float* xr = xrow_ptr(P, r) + c0;
#pragma unroll
                for (int bj = 0; bj < 2; ++bj) { xv[m][bj][0] = *(const f32x4*)(xr + 128 * bj); xv[m][bj][1] = *(const f32x4*)(xr + 128 * bj + 4); } }
#pragma unroll
            for (int m = 2 * (am & 1); m < 2 * (am & 1) + 2; ++m) { const int r = u.pm * 256 + 128 * ai + 64 * wr + 16 * m + fr; float* yr = (float*)(P.ws + WS_X1) + (size_t)r * DM + c0; bf16_t* hr = x1s + (size_t)r * DM + c0;
                float ss = 0.f;
#pragma unroll
                for (int bj = 0; bj < 2; ++bj) {
                    const f32x4 ya = xv[m][bj][0] + g1[bj][0] * acc[ai][bj][m][0], yb = xv[m][bj][1] + g1[bj][1] * acc[ai][bj][m][1];
                    *(f32x4*)(yr + 128 * bj) = ya; *(f32x4*)(yr + 128 * bj + 4) = yb;
                    ss += (ya[0] * ya[0] + ya[1] * ya[1]) + (ya[2] * ya[2] + ya[3] * ya[3]) + (yb[0] * yb[0] + yb[1] * yb[1]) + (yb[2] * yb[2] + yb[3] * yb[3]);
                    const f32x4 ha = ya * md[bj][0], hb = yb * md[bj][1]; u32x4 w; w.x = pk2(ha[0], ha[1]); w.y = pk2(ha[2], ha[3]); w.z = pk2(hb[0], hb[1]); w.w = pk2(hb[2], hb[3]); *(u32x4*)(hr + 128 * bj) = w; }
                ss += __shfl_xor(ss, 16); ss += __shfl_xor(ss, 32);
                if (fq == 0) unsafeAtomicAdd(ssq + r, ss); }
        }
    }
};
template <int CTRL> __device__ __forceinline__ float dpp_f(float v) { return __builtin_bit_cast(float, __builtin_amdgcn_update_dpp(0, __builtin_bit_cast(int, v), CTRL, 0xf, 0xf, true)); }
template <int CTRL> __device__ __forceinline__ f32x4 dpp4(f32x4 v) { return (f32x4){dpp_f<CTRL>(v[0]), dpp_f<CTRL>(v[1]), dpp_f<CTRL>(v[2]), dpp_f<CTRL>(v[3])}; }
constexpr int DPP_SHR1 = 0x111, DPP_SHL1 = 0x101, DPP_MIRROR = 0x140;
__device__ __forceinline__ f32x4 silu_mul4(f32x4 x, f32x4 u) {
    f32x4 r;
#pragma unroll
    for (int e = 0; e < 4; ++e) r[e] = x[e] * u[e] * __builtin_amdgcn_rcpf(1.0f + __builtin_amdgcn_exp2f(-1.4426950408889634f * x[e]));
    return r;
}
constexpr int XL_OFF = MISC_OFF + 128;
struct EpiGUConv {
    static constexpr bool PERM = false, AFTER_DRAIN = false;
    unsigned char* ws; const float* conv_w; const float* conv_b; LAS float* xl;
    __device__ __forceinline__ void operator()(f32x4 (&acc)[2][2][4][2], const Unit& u, int wr, int wc, int fr_, int fq_) const {
        int fr = fr_, fq = fq_; asm volatile("" : "+v"(fr), "+v"(fq));
        const bool prompt = u.pm < 16; const int i4 = (u.pm - 16) & 3; const bool first = prompt || i4 == 0, last = prompt || i4 == 3;
        const float* b2 = (const float*)(ws + WS_BIAS2) + (size_t)modrow_of_tile(u.pm) * NGU; const float* ssq = (const float*)(ws + WS_SSQ);
        bf16_t* Ab = (bf16_t*)(ws + WS_U);
        const int f0 = u.pn * 128 + 32 * wc + 8 * fq;
        {
            const f32x4 bg0 = *(const f32x4*)(b2 + f0), bg1 = *(const f32x4*)(b2 + f0 + 4), bu0 = *(const f32x4*)(b2 + DFF + f0), bu1 = *(const f32x4*)(b2 + DFF + f0 + 4);
            float tot[2][4];
#pragma unroll
            for (int ai = 0; ai < 2; ++ai)
#pragma unroll
                for (int m = 0; m < 4; ++m) tot[ai][m] = ssq[u.pm * 256 + 128 * ai + 64 * wr + 16 * m + fr];
#pragma unroll
            for (int ai = 0; ai < 2; ++ai)
#pragma unroll
                for (int m = 0; m < 4; ++m) {
                    const float rstd = rsqrtf(tot[ai][m] * (1.0f / DM) + EPS);
                    acc[ai][0][m][0] = acc[ai][0][m][0] * rstd + bg0; acc[ai][0][m][1] = acc[ai][0][m][1] * rstd + bg1;
                    acc[ai][1][m][0] = acc[ai][1][m][0] * rstd + bu0; acc[ai][1][m][1] = acc[ai][1][m][1] * rstd + bu1; }
        }
        LAS float* E = xl; LAS float* C = xl + 1024;
        const int eidx = (wc * 4 + fq) * 8;
        if (fr == 0) {
#pragma unroll
            for (int ai = 0; ai < 2; ++ai) { LAS float* p = E + ((wr * 2 + ai) * 2 + 0) * 128 + eidx; *(LAS f32x4*)p = acc[ai][0][0][0]; *(LAS f32x4*)(p + 4) = acc[ai][0][0][1]; } }
        if (fr == 15) {
#pragma unroll
            for (int ai = 0; ai < 2; ++ai) { LAS float* p = E + ((wr * 2 + ai) * 2 + 1) * 128 + eidx; *(LAS f32x4*)p = acc[ai][0][3][0]; *(LAS f32x4*)(p + 4) = acc[ai][0][3][1]; } }
        const f32x4 z4 = {0.f, 0.f, 0.f, 0.f};
        f32x4 c254[2] = {z4, z4}, c255[2] = {z4, z4}, cu[2] = {z4, z4};
        if (!first && wr == 0) { const LAS float* cp = C + (wc * 4 + fq) * 24;
            c254[0] = *(const LAS f32x4*)cp; c254[1] = *(const LAS f32x4*)(cp + 4); c255[0] = *(const LAS f32x4*)(cp + 8); c255[1] = *(const LAS f32x4*)(cp + 12); cu[0] = *(const LAS f32x4*)(cp + 16); cu[1] = *(const LAS f32x4*)(cp + 20); }
        LDS_WAIT(); __builtin_amdgcn_s_barrier(); asm volatile("" ::: "memory");
        if (!last && wr == 1) { LAS float* cp = C + (wc * 4 + fq) * 24;
            if (fr == 14) { *(LAS f32x4*)cp = acc[1][0][3][0]; *(LAS f32x4*)(cp + 4) = acc[1][0][3][1]; }
            if (fr == 15) { *(LAS f32x4*)(cp + 8) = acc[1][0][3][0]; *(LAS f32x4*)(cp + 12) = acc[1][0][3][1]; *(LAS f32x4*)(cp + 16) = acc[1][1][3][0]; *(LAS f32x4*)(cp + 20) = acc[1][1][3][1]; } }
        f32x4 w0[2], w1[2], w2[2], cb[2];
#pragma unroll
        for (int n = 0; n < 2; ++n) { w0[n] = *(const f32x4*)(conv_w + f0 + 4 * n); w1[n] = *(const f32x4*)(conv_w + DFF + f0 + 4 * n); w2[n] = *(const f32x4*)(conv_w + 2 * DFF + f0 + 4 * n); cb[n] = *(const f32x4*)(conv_b + f0 + 4 * n); }
        if (!first && wr == 0 && fr == 0) { u32x4 w;
            const f32x4 a0 = silu_mul4(w0[0] * c254[0] + w1[0] * c255[0] + w2[0] * acc[0][0][0][0] + cb[0], cu[0]), a1 = silu_mul4(w0[1] * c254[1] + w1[1] * c255[1] + w2[1] * acc[0][0][0][1] + cb[1], cu[1]);
            w.x = pk2(a0[0], a0[1]); w.y = pk2(a0[2], a0[3]); w.z = pk2(a1[0], a1[1]); w.w = pk2(a1[2], a1[3]); *(u32x4*)(Ab + (size_t)(u.pm * 256 - 1) * DFF + f0) = w; }
#pragma unroll
        for (int ai = 0; ai < 2; ++ai)
#pragma unroll
            for (int m = 0; m < 4; ++m) {
                f32x4 pe[2], ne[2];
                if (m == 0) { if (wr == 1) { const LAS float* p = E + ((0 * 2 + ai) * 2 + 1) * 128 + eidx; pe[0] = *(const LAS f32x4*)p; pe[1] = *(const LAS f32x4*)(p + 4); }
                              else if (ai == 1) { const LAS float* p = E + ((1 * 2 + 0) * 2 + 1) * 128 + eidx; pe[0] = *(const LAS f32x4*)p; pe[1] = *(const LAS f32x4*)(p + 4); }
                              else { pe[0] = c255[0]; pe[1] = c255[1]; } }
                if (m == 3) { if (wr == 0) { const LAS float* p = E + ((1 * 2 + ai) * 2 + 0) * 128 + eidx; ne[0] = *(const LAS f32x4*)p; ne[1] = *(const LAS f32x4*)(p + 4); }
                              else if (ai == 0) { const LAS float* p = E + ((0 * 2 + 1) * 2 + 0) * 128 + eidx; ne[0] = *(const LAS f32x4*)p; ne[1] = *(const LAS f32x4*)(p + 4); }
                              else { ne[0] = z4; ne[1] = z4; } }
                f32x4 a[2];
#pragma unroll
                for (int n = 0; n < 2; ++n) {
                    const f32x4 g = acc[ai][0][m][n];
                    const f32x4 pin = dpp4<DPP_SHR1>(g), nin = dpp4<DPP_SHL1>(g);
                    const f32x4 pout = (m > 0) ? dpp4<DPP_MIRROR>(acc[ai][0][m > 0 ? m - 1 : 0][n]) : pe[n];
                    const f32x4 nout = (m < 3) ? dpp4<DPP_MIRROR>(acc[ai][0][m < 3 ? m + 1 : 3][n]) : ne[n];
                    const f32x4 gp = (fr == 0) ? pout : pin, gn = (fr == 15) ? nout : nin;
                    a[n] = silu_mul4(w0[n] * gp + w1[n] * g + w2[n] * gn + cb[n], acc[ai][1][m][n]); }
                const int r = u.pm * 256 + 128 * ai + 64 * wr + 16 * m + fr;
                const bool deferred = !last && wr == 1 && ai == 1 && m == 3 && fr == 15;
                if (!deferred) { u32x4 w; w.x = pk2(a[0][0], a[0][1]); w.y = pk2(a[0][2], a[0][3]); w.z = pk2(a[1][0], a[1][1]); w.w = pk2(a[1][2], a[1][3]); *(u32x4*)(Ab + (size_t)r * DFF + f0) = w; }
            }
    }
};
struct ChainSched {
    int c, G;
    __device__ __forceinline__ bool next(int i, Unit& u) const {
        if (G == 256) {
            if (c < 176) { if (i >= 4) return false; u.pm = 16 + 4 * (c / 22) + i; u.pn = c % 22; return true; }
            const int t = (c - 176) + 80 * i; if (t >= 352) return false; u.pm = t / 22; u.pn = t % 22; return true;
        }
        const int ns = (c < 176) ? (175 - c) / G + 1 : 0;
        if (i < 4 * ns) { const int q = c + (i >> 2) * G; u.pm = 16 + 4 * (q / 22) + (i & 3); u.pn = q % 22; return true; }
        const int q = c + (ns + (i - 4 * ns)) * G; if (q >= 528) return false;
        const int t = q - 176; u.pm = t / 22; u.pn = t % 22; return true;
    }
    __device__ __forceinline__ void a_ready(const Unit&) const {}
    __device__ __forceinline__ void done(const Unit&) const {}
};
struct EpiDown {
    static constexpr bool PERM = false, AFTER_DRAIN = false;
    unsigned char* ws; float* out;
    __device__ __forceinline__ void operator()(const f32x4 (&acc)[2][2][4][2], const Unit& u, int wr, int wc, int fr_, int fq_) const {
        int fr = fr_, fq = fq_; asm volatile("" : "+v"(fr), "+v"(fq));
        const float* ada = (const float*)(ws + WS_ADA) + (size_t)modrow_of_tile(u.pm) * NADA;
        const int c0 = u.pn * 256 + 32 * wc + 8 * fq;
        f32x4 g2[2][2];
#pragma unroll
        for (int bj = 0; bj < 2; ++bj)
#pragma unroll
            for (int n = 0; n < 2; ++n) g2[bj][n] = *(const f32x4*)(ada + 5120 + c0 + 128 * bj + 4 * n);
#pragma unroll
        for (int ai = 0; ai < 2; ++ai) {
            f32x4 yv[4][2][2];
#pragma unroll
            for (int m = 0; m < 4; ++m) { const float* yr = (const float*)(ws + WS_X1) + (size_t)(u.pm * 256 + 128 * ai + 64 * wr + 16 * m + fr) * DM + c0;
#pragma unroll
                for (int bj = 0; bj < 2; ++bj)
#pragma unroll
                    for (int n = 0; n < 2; ++n) yv[m][bj][n] = *(const f32x4*)(yr + 128 * bj + 4 * n); }
#pragma unroll
            for (int m = 0; m < 4; ++m) { float* yr = out + (size_t)(u.pm * 256 + 128 * ai + 64 * wr + 16 * m + fr) * DM + c0;
#pragma unroll
                for (int bj = 0; bj < 2; ++bj)
#pragma unroll
                    for (int n = 0; n < 2; ++n) *(f32x4*)(yr + 128 * bj + 4 * n) = yv[m][bj][n] + g2[bj][n] * acc[ai][bj][m][n]; }
        }
    }
};
struct OneUnitSched {
    int has; Unit u0;
    __device__ __forceinline__ bool next(int i, Unit& u) const { if (i > 0 || !has) return false; u = u0; return true; }
    __device__ __forceinline__ void a_ready(const Unit&) const {}
    __device__ __forceinline__ void done(const Unit&) const {}
};

constexpr int N_PHASES = 8;
constexpr int N_LAUNCHES = MK_N_LAUNCHES;
struct StridedSched {
    int n, first, stride, npm;
    __device__ __forceinline__ bool next(int i, Unit& u) const { const int idx = first + i * stride; if (idx >= n) return false; u.pm = idx % npm; u.pn = idx / npm; return true; }
    __device__ __forceinline__ void a_ready(const Unit&) const {}
    __device__ __forceinline__ void done(const Unit&) const {}
};
__device__ __forceinline__ bool attn_next(int vcu, int G, int i, int& kind, int& idx) {
    if (G == 256) {
        if (vcu < 128) { if (i >= 2) return false; kind = 0; idx = 2 * vcu + i; return true; }
        const int v = vcu - 128;
        if (i == 0) { kind = 0; idx = 256 + v; return true; }
        if (v < 64 || i > 3) return false;
        kind = 1; idx = 3 * (v - 64) + i - 1; return true;
    }
    const int l = vcu + i * G; if (l >= 576) return false;
    if (l < 384) { kind = 0; idx = l; } else { kind = 1; idx = l - 384; }
    return true;
}
__global__ void __launch_bounds__(NWAVES * 64, 2) mk_fwd(Params P) {
    extern __shared__ __attribute__((aligned(16))) unsigned char lds_raw[];
    LAS unsigned char* lds = (LAS unsigned char*)lds_raw;
    const int tid = threadIdx.x, lane = tid & 63, wave = __builtin_amdgcn_readfirstlane(tid >> 6);
    const int G = gridDim.x, bx = blockIdx.x, vcu = (G % 8 == 0) ? (bx % 8) * (G / 8) + bx / 8 : bx;
    volatile LAS unsigned* MISC = (volatile LAS unsigned*)(lds + MISC_OFF);
    unsigned char* ws = P.ws;
    unsigned* ctl = (unsigned*)(ws + WS_CTL);
    for (int u = tid; u < (LDS_BYTES - LDSCTL_OFF) / 4; u += NWAVES * 64) ((LAS unsigned*)(lds + LDSCTL_OFF))[u] = 0u;
    __syncthreads();
    XcdBarrier bar; bar.bar = ctl + CW_BAR + P.li * XCD_BAR_WORDS; bar.x = 0; bar.st = nullptr;
    if (N_LAUNCHES != N_PHASES) bar = xcd_barrier_post(ctl + CW_BAR + P.li * XCD_BAR_WORDS, MISC + 8);
#define GRID_BAR() do { if (N_LAUNCHES != N_PHASES) xcd_barrier(bar); } while (0)
    const int lo = P.ph_lo, hi = P.ph_hi;
#ifndef PHASE_MASK
#define PHASE_MASK 0xff
#endif
#define IN(k) (((PHASE_MASK >> (k)) & 1) && lo <= (k) && (k) < hi)
#define BOTH(k) (IN(k) && IN((k) + 1))

    if (IN(0)) { p0_prep(P, lds, tid, lane, wave, vcu, G); if (BOTH(0)) GRID_BAR(); }
    if (IN(1)) { p1_norm(P, lds, tid, lane, wave, vcu, G); if (BOTH(1)) GRID_BAR(); }
    if (IN(2)) {
        pg8::Gemm g{(const bf16_t*)(ws + WS_H), (const bf16_t*)(ws + WS_WIN), NTOK, DIN, DM}; pg8::StaticOrder S; S.init(NTOK, DIN, G, bx);
        EpiInProj E{ws, P.out + (size_t)NTOK * DM, P.out + (size_t)NTOK * DM + (size_t)16 * NH * SP * 128, P.qg, P.kg};
        pg8::gemm_phase<EpiInProj, pg8::StaticOrder, true, true>(lds + RING_OFF, g, S, E);
        if (BOTH(2)) GRID_BAR();
    }
    if (IN(3)) {
        float lam, negref;
        { const float a = wave_sum(P.lq1[lane] * P.lk1[lane]), b2 = wave_sum(P.lq2[lane] * P.lk2[lane]); lam = expf(a) - expf(b2) + LAM_INIT;
          const float gq = wave_max(fabsf(P.qg[lane])), gk = wave_max(fabsf(P.kg[lane]));
          const float kmax2 = __uint_as_float(__hip_atomic_load(ctl + CW_KMAX, RLX_AGENT)); const float kmax = fmaxf(8.0f * gk, sqrtf(kmax2));
          negref = -(C2 * 8.0f * gq * kmax * 1.01f + 0.25f); }
#ifndef ATTN_OFF
        for (int i = 0; ; ++i) {
            int kind, idx; if (!attn_next(vcu, G, i, kind, idx)) break;
            const int bh = kind ? idx >> 1 : idx >> 3, qb = kind ? idx & 1 : idx & 7, b = bh / NH, h = bh - b * NH;
            const int Sq = kind ? SP : SS, Sk = kind ? SP : SKS;
            const bf16_t* Qh = (const bf16_t*)(ws + (kind ? WS_Q_P : WS_Q_S)) + (size_t)bh * 2 * Sq * 64;
            const bf16_t* Kh = (const bf16_t*)(ws + (kind ? WS_K_P : WS_K_S)) + (size_t)bh * 2 * Sk * 64;
            const bf16_t* Vh = (const bf16_t*)(ws + (kind ? WS_V_P : WS_V_S)) + (size_t)bh * Sk * 128;
            bf16_t* outp = (bf16_t*)(ws + WS_MIX) + (size_t)((kind ? 0 : NTOK_P) + b * Sq) * KOUT + 512 + h * 128;
            attn::attn_unit(lds, Qh, Kh, Vh, Sq, Sk, qb * 128, outp, lam, negref, P.subg);
        }
#endif
#ifndef FOURIER_OFF
        __syncthreads();
        { pg8::Gemm g{(const bf16_t*)(ws + WS_DFTS), (const bf16_t*)(ws + WS_XFT_S), 2048, 2048, SS};
          StridedSched S = (G == 256) ? StridedSched{64, (vcu >= 128 && vcu < 192) ? vcu - 128 : 64, 64, 8} : StridedSched{64, vcu, G, 8};
          EpiFourier E{(bf16_t*)(ws + WS_MIX), SS, NTOK_P};
          pg8::gemm_phase<EpiFourier, StridedSched, true, true>(lds + RING_OFF, g, S, E); }
        __syncthreads();
        { pg8::Gemm g{(const bf16_t*)(ws + WS_DFTP), (const bf16_t*)(ws + WS_XFT_P), 512, 4096, SP};
          StridedSched S = (G == 256) ? StridedSched{32, (vcu >= 192 && vcu < 224) ? vcu - 192 : 32, 32, 2} : StridedSched{32, vcu, G, 2};
          EpiFourier E{(bf16_t*)(ws + WS_MIX), SP, 0};
          pg8::gemm_phase<EpiFourier, StridedSched, true, true>(lds + RING_OFF, g, S, E); }
#endif
        if (BOTH(3)) GRID_BAR();
    }
    if (IN(4)) {
        pg8::Gemm g{(const bf16_t*)(ws + WS_MIX), (const bf16_t*)(ws + WS_WOUT), NTOK, DM, KOUT}; pg8::StaticOrder S; S.init(NTOK, DM, G, bx);
        EpiOut E{P};
        pg8::gemm_phase<EpiOut, pg8::StaticOrder, true, true>(lds + RING_OFF, g, S, E);
        { const int nt4 = (NTOK / 256) * (DM / 256), nidle = G - nt4;
          if (nidle > 0) { if (bx >= nt4) ffn_weight_items(P, lds, lane, wave, (bx - nt4) * NWAVES + wave, nidle * NWAVES); }
          else ffn_weight_items(P, lds, lane, wave, bx * NWAVES + wave, G * NWAVES); }
        if (BOTH(4)) GRID_BAR();
    }
    if (IN(5)) {
        pg8::Gemm g{(const bf16_t*)(ws + WS_H), (const bf16_t*)(ws + WS_WGU), NTOK, NGU, DM}; ChainSched S{bx, G};
        EpiGUConv E{ws, P.conv_w, P.conv_b, (LAS float*)(lds + XL_OFF)};
        pg8::gemm_phase<EpiGUConv, ChainSched, true, true>(lds + RING_OFF, g, S, E);
        if (BOTH(5)) GRID_BAR();
    }
    if (IN(7)) {
        pg8::Gemm g{(const bf16_t*)(ws + WS_U), (const bf16_t*)(ws + WS_WDN), NTOK, DM, DFF}; pg8::StaticOrder S; S.init(NTOK, DM, G, bx);
        EpiDown E{ws, P.out};
        pg8::gemm_phase<EpiDown, pg8::StaticOrder, true, true>(lds + RING_OFF, g, S, E);
    }
#undef IN
#undef BOTH
#undef GRID_BAR
}

extern "C" void kernel_launch(void* const* d_in, const int* in_sizes, int n_in, void* d_out, int out_size, void* d_ws, size_t ws_size, hipStream_t stream) {
    static int ok = 0;
    if (ok == 0) {
        if (n_in != 24 || ws_size < WS_END) { fprintf(stderr, "kernel_launch: expected 24 inputs and >= %zu bytes of workspace; got %d, %zu\n", (size_t)WS_END, n_in, ws_size); ok = -1; return; }
        if (hipFuncSetAttribute((const void*)mk_fwd, hipFuncAttributeMaxDynamicSharedMemorySize, LDS_BYTES) != hipSuccess) { fprintf(stderr, "kernel_launch: hipFuncSetAttribute failed\n"); ok = -1; return; }
        int per_cu = 0;
        if (hipOccupancyMaxActiveBlocksPerMultiprocessor(&per_cu, (const void*)mk_fwd, NWAVES * 64, LDS_BYTES) != hipSuccess || per_cu < 1) fprintf(stderr, "kernel_launch: note: occupancy query reports %d workgroups per CU\n", per_cu);
        (void)hipGetLastError();
        ok = 1;
    }
    if (ok < 0) return;
    (void)hipMemsetAsync((char*)d_ws + WS_CTL, 0, CTL_ZERO_BYTES, stream);
    Params a{};
    const float** pp = (const float**)&a;
    for (int i = 0; i < 24; ++i) pp[i] = (const float*)d_in[i];
    a.out = (float*)d_out; a.ws = (unsigned char*)d_ws;
#ifdef PROBE_PHASE
#ifndef PROBE_HI
#define PROBE_HI PROBE_PHASE
#endif
    const int nl = 2; const int plo[2] = {0, PROBE_PHASE}, phi[2] = {PROBE_HI + 1, N_PHASES};
#else
    const int nl = N_LAUNCHES; int plo[N_PHASES], phi[N_PHASES];
    for (int li = 0; li < N_LAUNCHES; ++li) { plo[li] = (N_LAUNCHES == 1) ? 0 : li; phi[li] = (N_LAUNCHES == 1) ? N_PHASES : li + 1; }
#endif
    for (int li = 0; li < nl; ++li) {
        a.ph_lo = plo[li]; a.ph_hi = phi[li]; a.li = li; a.pad = 0;
        hipLaunchKernelGGL(mk_fwd, dim3(256), dim3(NWAVES * 64), LDS_BYTES, stream, a);
        const hipError_t le = hipPeekAtLastError();
        if (le != hipSuccess) { fprintf(stderr, "kernel_launch: launch %d failed: %s\n", li, hipGetErrorName(le)); break; }
    }
}
```
